# Optimizing an MI355X kernel written in HIP

```python
import math
import jax, jax.numpy as jnp
from jax import lax
import numpy as np

D_MODEL = 1024
BATCH = 16
SEQ = 2048
DEPTH = 2
DEC_BATCH = 16
DEC_SEQ = 16
PAST_LEN = 1024

CHUNK = 64
Q_BLOCK = 128
N_EVEN = (DEPTH + 1) // 2
N_ODD = DEPTH // 2
EPS = 1e-6
NEG = -1e30
D_FF = 2816
A_HEADS = 8
A_HEAD_DIM = 64
A_PAST_CHUNKS = 8
A_BAND = (A_PAST_CHUNKS + 1) * CHUNK
A_REL_CLIP = 64
B_HEADS = 4
B_HEAD_DIM = 64
T5_BUCKETS = 32
T5_MAX_DIST = 128
C_HEADS = 16
C_NOPE = 64
C_ROPE = 32
C_V = 64
C_Q_LORA = 384
C_KV_LORA = 256
ROPE_THETA = 10000.0

A_W = A_HEADS * A_HEAD_DIM
B_W = B_HEADS * 2 * B_HEAD_DIM
E_IN_W = 3 * A_W + 3 * B_W
E_OUT_W = A_W + B_W
C_IN_W = C_Q_LORA + C_KV_LORA + C_ROPE

kernel_name = 'chunked_relbias_diffattn_mla_macaron_stream_step'

F32 = jnp.float32


def rmsnorm(x, g):
    x32 = x.astype(F32)
    y = x32 * lax.rsqrt(jnp.mean(x32 * x32, axis=-1, keepdims=True) + EPS)
    return (y * g.astype(F32)).astype(x.dtype)


def swiglu_ffn(x, g, w_gu, w_down):
    h = rmsnorm(x, g) @ w_gu
    gate, up = jnp.split(h, 2, axis=-1)
    return (jax.nn.silu(gate) * up) @ w_down


def masked_softmax(logits, mask):
    return jax.nn.softmax(jnp.where(mask, logits, NEG), axis=-1)


def chunk_causal_mask(q_pos, k_pos):
    return (k_pos[None, :] // CHUNK) <= (q_pos[:, None] // CHUNK)


def t5_bucket(rel):
    nb = T5_BUCKETS // 2
    max_exact = nb // 2
    ret = jnp.where(rel > 0, nb, 0)
    n = jnp.abs(rel)
    n_f = jnp.maximum(n, 1).astype(F32)
    large = max_exact + (jnp.log(n_f / max_exact) / math.log(T5_MAX_DIST / max_exact)
                         * (nb - max_exact)).astype(jnp.int32)
    large = jnp.minimum(large, nb - 1)
    return ret + jnp.where(n < max_exact, n, large)


def rope(x, pos):
    half = x.shape[-1] // 2
    inv = ROPE_THETA ** (-jnp.arange(half, dtype=F32) / half)
    ang = pos.astype(F32)[:, None] * inv[None, :]
    cos = jnp.cos(ang)[None, :, None, :]
    sin = jnp.sin(ang)[None, :, None, :]
    x32 = x.astype(F32)
    x1, x2 = x32[..., :half], x32[..., half:]
    return jnp.concatenate([x1 * cos - x2 * sin, x1 * sin + x2 * cos], axis=-1).astype(x.dtype)


def sweep_queries(fn, n_q, *q_arrays):
    def blk(i):
        start = i * Q_BLOCK
        qs = [lax.dynamic_slice_in_dim(a, start, Q_BLOCK, axis=1) for a in q_arrays]
        return fn(start + jnp.arange(Q_BLOCK), *qs)
    out = lax.map(blk, jnp.arange(n_q // Q_BLOCK))
    out = jnp.moveaxis(out, 0, 1)
    return out.reshape((out.shape[0], n_q) + out.shape[3:])


def a_attend(q, k, v, q_pos, k_pos, rel_table):
    logits = jnp.einsum('bqhd,bkhd->bhqk', q, k, preferred_element_type=F32) * (A_HEAD_DIM ** -0.5)
    rel = jnp.clip(q_pos[:, None] - k_pos[None, :], -A_REL_CLIP, A_REL_CLIP) + A_REL_CLIP
    logits = logits + rel_table[:, rel].astype(F32)
    qc, kc = q_pos[:, None] // CHUNK, k_pos[None, :] // CHUNK
    mask = (k_pos[None, :] >= 0) & (kc <= qc) & (kc >= qc - A_PAST_CHUNKS)
    p = masked_softmax(logits, mask)
    return jnp.einsum('bhqk,bkhd->bqhd', p.astype(v.dtype), v)


def a_prompt(q, k, v, rel_table):
    b, s = q.shape[:2]
    pad = A_PAST_CHUNKS * CHUNK
    kp = jnp.pad(k, ((0, 0), (pad, 0), (0, 0), (0, 0)))
    vp = jnp.pad(v, ((0, 0), (pad, 0), (0, 0), (0, 0)))

    def one_chunk(c):
        start = c * CHUNK
        qc = lax.dynamic_slice_in_dim(q, start, CHUNK, axis=1)
        kb = lax.dynamic_slice_in_dim(kp, start, A_BAND, axis=1)
        vb = lax.dynamic_slice_in_dim(vp, start, A_BAND, axis=1)
        q_pos = start + jnp.arange(CHUNK)
        k_pos = start - pad + jnp.arange(A_BAND)
        return a_attend(qc, kb, vb, q_pos, k_pos, rel_table)

    out = lax.map(one_chunk, jnp.arange(s // CHUNK))
    return jnp.moveaxis(out, 0, 1).reshape(b, s, A_HEADS, A_HEAD_DIM)


def a_sample(q, k, v, cache_k, cache_v, q_pos, rel_table):
    n_c = cache_k.shape[1]
    k_all = jnp.concatenate([cache_k, k], axis=1)
    v_all = jnp.concatenate([cache_v, v], axis=1)
    k_pos = jnp.concatenate([PAST_LEN - n_c + jnp.arange(n_c), q_pos])
    return a_attend(q, k_all, v_all, q_pos, k_pos, rel_table)


def diff_lambda(lq1, lk1, lq2, lk2, lam_init):
    return (jnp.exp(jnp.sum(lq1.astype(F32) * lk1.astype(F32)))
            - jnp.exp(jnp.sum(lq2.astype(F32) * lk2.astype(F32))) + lam_init)


def b_attend(q, k, v, q_pos, k_pos, t5_table, lam):
    q2 = q.reshape(q.shape[:3] + (2, B_HEAD_DIM))
    k2 = k.reshape(k.shape[:3] + (2, B_HEAD_DIM))
    logits = jnp.einsum('bqhmd,bkhmd->bhmqk', q2, k2, preferred_element_type=F32) * (B_HEAD_DIM ** -0.5)
    bias = t5_table[t5_bucket(k_pos[None, :] - q_pos[:, None])]
    logits = logits + jnp.transpose(bias, (2, 0, 1))[:, None].astype(F32)
    p = masked_softmax(logits, chunk_causal_mask(q_pos, k_pos))
    w = p[:, :, 0] - lam * p[:, :, 1]
    return jnp.einsum('bhqk,bkhe->bqhe', w.astype(v.dtype), v)


def even_project(h, w_in):
    b, s, _ = h.shape
    cuts = [A_W, 2 * A_W, 3 * A_W, 3 * A_W + B_W, 3 * A_W + 2 * B_W]
    aq, ak, av, bq, bk, bv = jnp.split(h @ w_in, cuts, axis=-1)
    ra = lambda t: t.reshape(b, s, A_HEADS, A_HEAD_DIM)
    rb = lambda t: t.reshape(b, s, B_HEADS, 2 * B_HEAD_DIM)
    return ra(aq), ra(ak), ra(av), rb(bq), rb(bk), rb(bv)


def even_merge(a_out, b_out, lam_init, subln_g, w_out):
    b, s = a_out.shape[:2]
    b_n = rmsnorm(b_out, subln_g) * (1.0 - lam_init)
    o = jnp.concatenate([a_out.reshape(b, s, A_W), b_n.reshape(b, s, B_W)], axis=-1)
    return o @ w_out


def c_project(h, pos, w_in, g_q, g_kv, w_q_up):
    b, s, _ = h.shape
    cq, ckv, kr = jnp.split(h @ w_in, [C_Q_LORA, C_Q_LORA + C_KV_LORA], axis=-1)
    q = (rmsnorm(cq, g_q) @ w_q_up).reshape(b, s, C_HEADS, C_NOPE + C_ROPE)
    q_nope = q[..., :C_NOPE]
    q_rope = rope(q[..., C_NOPE:], pos)
    ckv = rmsnorm(ckv, g_kv)
    kr = rope(kr[:, :, None, :], pos)[:, :, 0, :]
    return q_nope, q_rope, ckv, kr


def c_expand(c_kv, w_kv_up):
    b, k, _ = c_kv.shape
    kv = (c_kv @ w_kv_up).reshape(b, k, C_HEADS, C_NOPE + C_V)
    return kv[..., :C_NOPE], kv[..., C_NOPE:]


def c_attend(q_nope, q_rope, k_nope, v, k_rope, q_pos, k_pos):
    scale = (C_NOPE + C_ROPE) ** -0.5
    logits = (jnp.einsum('bqhd,bkhd->bhqk', q_nope, k_nope, preferred_element_type=F32)
              + jnp.einsum('bqhr,bkr->bhqk', q_rope, k_rope, preferred_element_type=F32)) * scale
    p = masked_softmax(logits, chunk_causal_mask(q_pos, k_pos))
    return jnp.einsum('bhqk,bkhd->bqhd', p.astype(v.dtype), v)


def setup_inputs(seed: int = 0) -> dict:
    key = jax.random.key(seed)
    ks = iter(jax.random.split(key, 40))
    nrm = lambda shape, scale: jax.random.normal(next(ks), shape, F32) * scale
    gain = lambda shape: 1.0 + 0.01 * jax.random.normal(next(ks), shape, F32)
    a_cache = min(A_PAST_CHUNKS * CHUNK, PAST_LEN)
    return {
        'x_prompt': nrm((BATCH, SEQ, D_MODEL), 1.0),
        'x_sample': nrm((DEC_BATCH, DEC_SEQ, D_MODEL), 1.0),
        'cache_a_k': nrm((N_EVEN, DEC_BATCH, a_cache, A_HEADS, A_HEAD_DIM), 1.0),
        'cache_a_v': nrm((N_EVEN, DEC_BATCH, a_cache, A_HEADS, A_HEAD_DIM), 1.0),
        'cache_b_k': nrm((N_EVEN, DEC_BATCH, PAST_LEN, B_HEADS, 2 * B_HEAD_DIM), 1.0),
        'cache_b_v': nrm((N_EVEN, DEC_BATCH, PAST_LEN, B_HEADS, 2 * B_HEAD_DIM), 1.0),
        'cache_c_kv': nrm((N_ODD, DEC_BATCH, PAST_LEN, C_KV_LORA), 1.0),
        'cache_c_kr': nrm((N_ODD, DEC_BATCH, PAST_LEN, C_ROPE), 1.0),
        't5_bias': nrm((T5_BUCKETS, B_HEADS), 0.2),
        'ffn1_norm': gain((DEPTH, D_MODEL)),
        'ffn1_w_gu': nrm((DEPTH, D_MODEL, 2 * D_FF), D_MODEL ** -0.5),
        'ffn1_w_down': nrm((DEPTH, D_FF, D_MODEL), D_FF ** -0.5),
        'mix_norm': gain((DEPTH, D_MODEL)),
        'ffn2_norm': gain((DEPTH, D_MODEL)),
        'ffn2_w_gu': nrm((DEPTH, D_MODEL, 2 * D_FF), D_MODEL ** -0.5),
        'ffn2_w_down': nrm((DEPTH, D_FF, D_MODEL), D_FF ** -0.5),
        'e_w_in': nrm((N_EVEN, D_MODEL, E_IN_W), D_MODEL ** -0.5),
        'a_rel_bias': nrm((N_EVEN, A_HEADS, 2 * A_REL_CLIP + 1), 0.2),
        'b_lambda_q1': nrm((N_EVEN, B_HEAD_DIM), 0.1),
        'b_lambda_k1': nrm((N_EVEN, B_HEAD_DIM), 0.1),
        'b_lambda_q2': nrm((N_EVEN, B_HEAD_DIM), 0.1),
        'b_lambda_k2': nrm((N_EVEN, B_HEAD_DIM), 0.1),
        'b_subln': gain((N_EVEN, 2 * B_HEAD_DIM)),
        'e_w_out': nrm((N_EVEN, E_OUT_W, D_MODEL), E_OUT_W ** -0.5),
        'c_w_in': nrm((N_ODD, D_MODEL, C_IN_W), D_MODEL ** -0.5),
        'c_q_norm': gain((N_ODD, C_Q_LORA)),
        'c_kv_norm': gain((N_ODD, C_KV_LORA)),
        'c_w_q_up': nrm((N_ODD, C_Q_LORA, C_HEADS * (C_NOPE + C_ROPE)), C_Q_LORA ** -0.5),
        'c_w_kv_up': nrm((N_ODD, C_KV_LORA, C_HEADS * (C_NOPE + C_V)), C_KV_LORA ** -0.5),
        'c_w_out': nrm((N_ODD, C_HEADS * C_V, D_MODEL), (C_HEADS * C_V) ** -0.5),
        'final_norm': gain((D_MODEL,)),
    }


def reference(x_prompt, x_sample, cache_a_k, cache_a_v, cache_b_k, cache_b_v, cache_c_kv, cache_c_kr,
              t5_bias, ffn1_norm, ffn1_w_gu, ffn1_w_down, mix_norm, ffn2_norm, ffn2_w_gu, ffn2_w_down,
              e_w_in, a_rel_bias, b_lambda_q1, b_lambda_k1, b_lambda_q2, b_lambda_k2, b_subln, e_w_out,
              c_w_in, c_q_norm, c_kv_norm, c_w_q_up, c_w_kv_up, c_w_out, final_norm):
    yp, ys = x_prompt, x_sample
    seq, t_new = x_prompt.shape[1], x_sample.shape[1]
    pos_p = jnp.arange(seq)
    pos_s = PAST_LEN + jnp.arange(t_new)
    pos_all_s = jnp.arange(PAST_LEN + t_new)
    a_keep = min(A_PAST_CHUNKS * CHUNK, seq)
    pak, pav, pbk, pbv, pckv, pckr = [], [], [], [], [], []
    sak, sav, sbk, sbv, sckv, sckr = [], [], [], [], [], []

    for layer in range(DEPTH):
        yp = yp + 0.5 * swiglu_ffn(yp, ffn1_norm[layer], ffn1_w_gu[layer], ffn1_w_down[layer])
        ys = ys + 0.5 * swiglu_ffn(ys, ffn1_norm[layer], ffn1_w_gu[layer], ffn1_w_down[layer])
        hp = rmsnorm(yp, mix_norm[layer])
        hs = rmsnorm(ys, mix_norm[layer])
        if layer % 2 == 0:
            e = layer // 2
            lam_init = 0.8 - 0.6 * math.exp(-0.3 * layer)
            lam = diff_lambda(b_lambda_q1[e], b_lambda_k1[e], b_lambda_q2[e], b_lambda_k2[e], lam_init)
            aq, ak, av, bq, bk, bv = even_project(hp, e_w_in[e])
            a_out = a_prompt(aq, ak, av, a_rel_bias[e])
            b_out = sweep_queries(lambda qp, qb: b_attend(qb, bk, bv, qp, pos_p, t5_bias, lam), seq, bq)
            yp = yp + even_merge(a_out, b_out, lam_init, b_subln[e], e_w_out[e])
            pak.append(ak[:, seq - a_keep:])
            pav.append(av[:, seq - a_keep:])
            pbk.append(bk)
            pbv.append(bv)
            aq, ak, av, bq, bk, bv = even_project(hs, e_w_in[e])
            a_out = a_sample(aq, ak, av, cache_a_k[e], cache_a_v[e], pos_s, a_rel_bias[e])
            kb_all = jnp.concatenate([cache_b_k[e], bk], axis=1)
            vb_all = jnp.concatenate([cache_b_v[e], bv], axis=1)
            b_out = b_attend(bq, kb_all, vb_all, pos_s, pos_all_s, t5_bias, lam)
            ys = ys + even_merge(a_out, b_out, lam_init, b_subln[e], e_w_out[e])
            sak.append(ak)
            sav.append(av)
            sbk.append(bk)
            sbv.append(bv)
        else:
            o = layer // 2
            qn, qr, ckv, kr = c_project(hp, pos_p, c_w_in[o], c_q_norm[o], c_kv_norm[o], c_w_q_up[o])
            kn, vv = c_expand(ckv, c_w_kv_up[o])
            c_out = sweep_queries(lambda qp, a, b: c_attend(a, b, kn, vv, kr, qp, pos_p), seq, qn, qr)
            yp = yp + c_out.reshape(c_out.shape[0], seq, C_HEADS * C_V) @ c_w_out[o]
            pckv.append(ckv)
            pckr.append(kr)
            qn, qr, ckv, kr = c_project(hs, pos_s, c_w_in[o], c_q_norm[o], c_kv_norm[o], c_w_q_up[o])
            ckv_all = jnp.concatenate([cache_c_kv[o], ckv], axis=1)
            kr_all = jnp.concatenate([cache_c_kr[o], kr], axis=1)
            kn, vv = c_expand(ckv_all, c_w_kv_up[o])
            c_out = c_attend(qn, qr, kn, vv, kr_all, pos_s, pos_all_s)
            ys = ys + c_out.reshape(c_out.shape[0], t_new, C_HEADS * C_V) @ c_w_out[o]
            sckv.append(ckv)
            sckr.append(kr)
        yp = yp + 0.5 * swiglu_ffn(yp, ffn2_norm[layer], ffn2_w_gu[layer], ffn2_w_down[layer])
        ys = ys + 0.5 * swiglu_ffn(ys, ffn2_norm[layer], ffn2_w_gu[layer], ffn2_w_down[layer])

    y_prompt = rmsnorm(yp, final_norm)
    y_sample = rmsnorm(ys, final_norm)
    p_a_k, p_a_v = jnp.stack(pak), jnp.stack(pav)
    p_b_k, p_b_v = jnp.stack(pbk), jnp.stack(pbv)
    p_c_kv, p_c_kr = jnp.stack(pckv), jnp.stack(pckr)
    s_a_k, s_a_v = jnp.stack(sak), jnp.stack(sav)
    s_b_k, s_b_v = jnp.stack(sbk), jnp.stack(sbv)
    s_c_kv, s_c_kr = jnp.stack(sckv), jnp.stack(sckr)
    return (y_prompt, y_sample, p_a_k, p_a_v, p_b_k, p_b_v, p_c_kv, p_c_kr,
            s_a_k, s_a_v, s_b_k, s_b_v, s_c_kv, s_c_kr)
```

```cpp
#include <hip/hip_runtime.h>
#include <cstdio>
#include <cstdint>
namespace pg8 {
#define PG8_LAS __attribute__((address_space(3)))
typedef unsigned short bf16_t;
typedef short bf16x8 __attribute__((ext_vector_type(8)));
typedef float f32x4 __attribute__((ext_vector_type(4)));
typedef unsigned u32x4 __attribute__((ext_vector_type(4)));
constexpr int BM = 256, BK = 64, HALF = 128, HTB = HALF * BK * 2  , STAGE_BYTES = 8 * HTB, NXCD = 8, WGM = 8;

__host__ __device__ __forceinline__ int lds_byte(int r, int c) { const int st = (r >> 4) * 2 + (c >> 5), rr = r & 15, cc = c & 31, ob = rr * 64 + cc * 2; return st * 1024 + (ob ^ (((ob >> 9) & 1) << 5)); }
__host__ __device__ __forceinline__ void stage_rc(int b, int& R, int& C) { const int st = b / 1024, sb = b % 1024, swz = sb ^ (((sb >> 9) & 1) << 5); R = (st >> 1) * 16 + swz / 64; C = (st & 1) * 32 + (swz % 64) / 2; }
__host__ __device__ __forceinline__ int perm32(int rho) { const int n = rho >> 4, i = rho & 15; return 8 * (i >> 2) + 4 * n + (i & 3); }

struct Unit { int pm, pn; };
struct Gemm { const bf16_t* A; const bf16_t* Bt; int M, N, K; };

struct StaticOrder {
    int nM, nN, nwg, G, c;
    __host__ __device__ void init(int M, int N, int G_, int c_) { nM = M / BM; nN = N / BM; nwg = nM * nN; G = G_; c = c_; }
    __host__ __device__ bool next(int i, Unit& u) const {
        const long L = (long)i * G + c; if (L >= nwg) return false;
        int wgid = (int)L; { const int q = nwg / NXCD, r = nwg % NXCD, xcd = wgid % NXCD, off = wgid / NXCD; wgid = (xcd < r ? xcd * (q + 1) : r * (q + 1) + (xcd - r) * q) + off; }
        const int nig = WGM * nN, gid = wgid / nig, fm = gid * WGM, gsz = (nM - fm) < WGM ? (nM - fm) : WGM;
        u.pm = fm + ((wgid % nig) % gsz); u.pn = (wgid % nig) / gsz; return true;
    }
    __device__ __forceinline__ void a_ready(const Unit&) const {}
    __device__ __forceinline__ void done(const Unit&) const {}
};
__device__ __forceinline__ unsigned cvt_pk_bf16(float lo, float hi) { unsigned r; asm volatile("v_cvt_pk_bf16_f32 %0, %1, %2" : "=v"(r) : "v"(lo), "v"(hi)); return r; }
template <class Epi, class Sched, bool ALIGN_EPI = false, bool SP2 = false>
__device__ __forceinline__ void gemm_phase(PG8_LAS unsigned char* lds, const Gemm g, const Sched& S, const Epi& E) {
    const int tid = threadIdx.x, wid = __builtin_amdgcn_readfirstlane(tid >> 6), lane = tid & 63, wr = wid >> 2, wc = wid & 3, fr = lane & 15, fq = lane >> 4;
    const int K = g.K, nt = K / BK;
    unsigned voffA[2], voffB[2];
#pragma unroll
    for (int i = 0; i < 2; ++i) { int R, C; stage_rc(tid * 16 + i * 8192, R, C); const int Rb = Epi::PERM ? ((R & ~31) + perm32(R & 31)) : R;
        voffA[i] = (unsigned)(R * K + C) * 2u; voffB[i] = (unsigned)(Rb * K + C) * 2u; }
    const size_t kstep = (size_t)(BK * 2);
    const size_t hstep = (size_t)HALF * K * 2;
    const size_t tstep = 2 * hstep;
    const unsigned ldsw = (unsigned)wid * 1024u;
    const int aoff = lds_byte(wr * 64 + fr, fq * 8), boff = lds_byte(wc * 32 + fr, fq * 8);
#define PG8_SA(b, h) (((b) * 2 + (h)) * HTB)
#define PG8_SB(b, h) ((4 + (b) * 2 + (h)) * HTB)
#define PG8_STAGE(bufoff, gbase, voff) do { _Pragma("unroll") for (int _i = 0; _i < 2; ++_i) \
        __builtin_amdgcn_global_load_lds((const unsigned*)((const char*)(gbase) + (voff)[_i]), (PG8_LAS unsigned*)(lds + (bufoff) + ldsw + _i * 8192), 16, 0, 0); } while (0)
#define PG8_LDA(dst, b, h) do { _Pragma("unroll") for (int m = 0; m < 4; ++m) _Pragma("unroll") for (int k = 0; k < 2; ++k) dst[m][k] = *(const PG8_LAS bf16x8*)(lds + PG8_SA(b, h) + aoff + m * 2048 + k * 1024); } while (0)
#define PG8_LDB(dst, b, h) do { _Pragma("unroll") for (int n = 0; n < 2; ++n) _Pragma("unroll") for (int k = 0; k < 2; ++k) dst[n][k] = *(const PG8_LAS bf16x8*)(lds + PG8_SB(b, h) + boff + n * 2048 + k * 1024); } while (0)
#define PG8_MMA(ai, bj, At, Bt) do { __builtin_amdgcn_s_setprio(1); _Pragma("unroll") for (int m = 0; m < 4; ++m) _Pragma("unroll") for (int n = 0; n < 2; ++n) _Pragma("unroll") for (int k = 0; k < 2; ++k) \
        acc[ai][bj][m][n] = __builtin_amdgcn_mfma_f32_16x16x32_bf16(Bt[n][k], At[m][k], acc[ai][bj][m][n], 0, 0, 0); __builtin_amdgcn_s_setprio(0); } while (0)
#define PG8_WAIT_V(n) asm volatile("s_waitcnt vmcnt(" #n ")" ::: "memory")
#define PG8_WAIT_L(n) asm volatile("s_waitcnt lgkmcnt(" #n ")" ::: "memory")
#define PG8_BAR __builtin_amdgcn_s_barrier()
#define PG8_SCHED __builtin_amdgcn_sched_barrier(0)
    Unit cur, nxt; int ui = 0;
    if (!S.next(0, cur)) return;
    f32x4 acc[2][2][4][2];
#pragma unroll
    for (int a = 0; a < 2; ++a)
#pragma unroll
        for (int b = 0; b < 2; ++b)
#pragma unroll
            for (int m = 0; m < 4; ++m)
#pragma unroll
                for (int n = 0; n < 2; ++n) acc[a][b][m][n] = (f32x4){0.f, 0.f, 0.f, 0.f};
    bf16x8 At[4][2], B0[2][2], B1[2][2];
    const char* cA = (const char*)g.A + (size_t)cur.pm * tstep; const char* cB = (const char*)g.Bt + (size_t)cur.pn * tstep;
    S.a_ready(cur);
    if constexpr (SP2) {
        PG8_STAGE(PG8_SB(0, 0), cB, voffB); PG8_STAGE(PG8_SB(0, 1), cB + hstep, voffB); PG8_STAGE(PG8_SA(0, 0), cA, voffA); PG8_STAGE(PG8_SA(0, 1), cA + hstep, voffA);
        if (wr == 1) PG8_BAR;
        PG8_WAIT_V(2); PG8_BAR;
        PG8_STAGE(PG8_SB(1, 0), cB + kstep, voffB); PG8_STAGE(PG8_SA(1, 0), cA + kstep, voffA); PG8_STAGE(PG8_SB(1, 1), cB + hstep + kstep, voffB);
        PG8_WAIT_V(6); PG8_BAR;
    } else {
        PG8_STAGE(PG8_SB(0, 0), cB, voffB); PG8_STAGE(PG8_SA(0, 0), cA, voffA); PG8_STAGE(PG8_SB(0, 1), cB + hstep, voffB); PG8_STAGE(PG8_SA(0, 1), cA + hstep, voffA);
        if (wr == 1) PG8_BAR;
        PG8_WAIT_V(4); PG8_BAR;
        PG8_STAGE(PG8_SB(1, 0), cB + kstep, voffB); PG8_STAGE(PG8_SA(1, 0), cA + kstep, voffA); PG8_STAGE(PG8_SB(1, 1), cB + hstep + kstep, voffB);
        PG8_WAIT_V(6); PG8_BAR;
    }
    for (;;) {
        const bool has_next = S.next(ui + 1, nxt);
        const char* nA = has_next ? (const char*)g.A + (size_t)nxt.pm * tstep : cA; const char* nB = has_next ? (const char*)g.Bt + (size_t)nxt.pn * tstep : cB;
        for (int t = 0; t < nt; t += 2) {
            const bool last = (t == nt - 2);
            const char* a1 = cA + (size_t)(t + 1) * kstep;
            const char* a2 = last ? nA : cA + (size_t)(t + 2) * kstep; const char* b2 = last ? nB : cB + (size_t)(t + 2) * kstep;
            const char* a3 = a2 + kstep; const char* b3 = b2 + kstep;
            if (last && has_next) S.a_ready(nxt);
            if constexpr (SP2) {
            PG8_LDB(B0, 0, 0); PG8_LDB(B1, 0, 1); PG8_SCHED; PG8_LDA(At, 0, 0); PG8_STAGE(PG8_SA(1, 1), a1 + hstep, voffA);
            PG8_WAIT_V(8); PG8_WAIT_L(0); PG8_BAR; PG8_MMA(0, 0, At, B0); PG8_MMA(0, 1, At, B1); PG8_BAR; PG8_SCHED;
            PG8_LDA(At, 0, 1); PG8_STAGE(PG8_SB(0, 0), b2, voffB); PG8_STAGE(PG8_SB(0, 1), b2 + hstep, voffB); PG8_STAGE(PG8_SA(0, 0), a2, voffA);
            PG8_WAIT_V(8); PG8_WAIT_L(0); PG8_BAR; PG8_MMA(1, 0, At, B0); PG8_MMA(1, 1, At, B1); PG8_BAR; PG8_SCHED;
            PG8_LDB(B0, 1, 0); PG8_LDB(B1, 1, 1); PG8_SCHED; PG8_LDA(At, 1, 0); PG8_STAGE(PG8_SA(0, 1), a2 + hstep, voffA);
            PG8_WAIT_V(8); PG8_WAIT_L(0); PG8_BAR; PG8_MMA(0, 0, At, B0); PG8_MMA(0, 1, At, B1); PG8_BAR; PG8_SCHED;
            PG8_LDA(At, 1, 1); PG8_STAGE(PG8_SB(1, 0), b3, voffB); PG8_STAGE(PG8_SB(1, 1), b3 + hstep, voffB); PG8_STAGE(PG8_SA(1, 0), a3, voffA);
            PG8_WAIT_V(8); PG8_WAIT_L(0); PG8_BAR; PG8_MMA(1, 0, At, B0); PG8_MMA(1, 1, At, B1); PG8_BAR; PG8_SCHED;
            } else {
            PG8_LDB(B0, 0, 0); PG8_SCHED; PG8_LDA(At, 0, 0); PG8_STAGE(PG8_SA(1, 1), a1 + hstep, voffA);
            PG8_WAIT_L(8); PG8_BAR; PG8_WAIT_L(0); PG8_MMA(0, 0, At, B0); PG8_BAR; PG8_SCHED;
            PG8_LDB(B1, 0, 1); PG8_STAGE(PG8_SB(0, 0), b2, voffB);
            PG8_BAR; PG8_WAIT_L(0); PG8_MMA(0, 1, At, B1); PG8_BAR;
            PG8_LDA(At, 0, 1); PG8_STAGE(PG8_SA(0, 0), a2, voffA);
            PG8_BAR; PG8_WAIT_L(0); PG8_MMA(1, 0, At, B0); PG8_BAR; PG8_SCHED;
            PG8_STAGE(PG8_SB(0, 1), b2 + hstep, voffB);
            PG8_WAIT_V(6); PG8_BAR; PG8_MMA(1, 1, At, B1); PG8_BAR;
            PG8_LDB(B0, 1, 0); PG8_SCHED; PG8_LDA(At, 1, 0); PG8_STAGE(PG8_SA(0, 1), a2 + hstep, voffA);
            PG8_WAIT_L(8); PG8_BAR; PG8_WAIT_L(0); PG8_MMA(0, 0, At, B0); PG8_BAR; PG8_SCHED;
            PG8_LDB(B1, 1, 1); PG8_STAGE(PG8_SB(1, 0), b3, voffB);
            PG8_BAR; PG8_WAIT_L(0); PG8_MMA(0, 1, At, B1); PG8_BAR;
            PG8_LDA(At, 1, 1); PG8_STAGE(PG8_SA(1, 0), a3, voffA);
            PG8_BAR; PG8_WAIT_L(0); PG8_MMA(1, 0, At, B0); PG8_BAR; PG8_SCHED;
            PG8_STAGE(PG8_SB(1, 1), b3 + hstep, voffB);
            PG8_WAIT_V(6); PG8_BAR; PG8_MMA(1, 1, At, B1); PG8_BAR;
            }
        }
        if constexpr (ALIGN_EPI) { if (wr == 0) PG8_BAR; }
        if constexpr (!Epi::AFTER_DRAIN) { E(acc, cur, wr, wc, fr, fq); S.done(cur); }
        if (!has_next) break;
#pragma unroll
        for (int a = 0; a < 2; ++a)
#pragma unroll
            for (int b = 0; b < 2; ++b)
#pragma unroll
                for (int m = 0; m < 4; ++m)
#pragma unroll
                    for (int n = 0; n < 2; ++n) acc[a][b][m][n] = (f32x4){0.f, 0.f, 0.f, 0.f};
        cur = nxt; cA = nA; cB = nB; ++ui;
        if constexpr (ALIGN_EPI) { if (wr == 1) PG8_BAR; }
    }
    PG8_WAIT_V(0);
    if constexpr (!ALIGN_EPI) { if (wr == 0) PG8_BAR; }
    PG8_BAR;
    if constexpr (Epi::AFTER_DRAIN) { E.fused(acc, cur, wr, wc, fr, fq, lds, wid, lane); S.done(cur); }
#undef PG8_SA
#undef PG8_SB
#undef PG8_STAGE
#undef PG8_LDA
#undef PG8_LDB
#undef PG8_MMA
#undef PG8_WAIT_V
#undef PG8_WAIT_L
#undef PG8_BAR
#undef PG8_SCHED
}
}

#include <hip/hip_cooperative_groups.h>
namespace cg = cooperative_groups;
#define LAS __attribute__((address_space(3)))
typedef unsigned short bf16_t;
typedef short bf16x8 __attribute__((ext_vector_type(8)));
typedef short s16x4 __attribute__((ext_vector_type(4)));
typedef float f32x4 __attribute__((ext_vector_type(4)));
typedef float f32x16 __attribute__((ext_vector_type(16)));
typedef unsigned u32x4 __attribute__((ext_vector_type(4)));
typedef unsigned u32x2 __attribute__((ext_vector_type(2)));
using pg8::cvt_pk_bf16;

constexpr int TP = 32768, TS = 256, MT = TP + TS;
constexpr int D = 1024, FF = 2816, SEQ = 2048, NB = 16, NEW = 16, PAST = 1024;
constexpr int SROWS_C = NB * (PAST + NEW);
constexpr int MKV = TP + SROWS_C;
constexpr int KA_ROWS = 576, KB_ROWS = 1088;
constexpr float EPS = 1e-6f, LOG2E = 1.4426950408889634f;
constexpr float QS_AB = 0.125f * LOG2E;
constexpr float QS_C = 0.10206207261596575f * LOG2E;
constexpr float NEGBIG = -1e30f;

constexpr size_t O_Y = 0, O_PAK = (size_t)MT * D, O_PAV = O_PAK + 4194304, O_PBK = O_PAV + 4194304, O_PBV = O_PBK + 16777216,
                 O_PCKV = O_PBV + 16777216, O_PCKR = O_PCKV + 8388608, O_SAK = O_PCKR + 1048576, O_SAV = O_SAK + 131072,
                 O_SBK = O_SAV + 131072, O_SBV = O_SBK + 131072, O_SCKV = O_SBV + 131072, O_SCKR = O_SCKV + 65536, O_END = O_SCKR + 8192;
static_assert(O_END == 85794816, "d_out map");

constexpr size_t al256(size_t x) { return (x + 255) & ~(size_t)255; }
constexpr size_t W_GU = 0;
constexpr size_t W_GU_SZ = (size_t)5632 * 1024 * 2;
constexpr size_t W_DN = W_GU + 4 * W_GU_SZ;
constexpr size_t W_DN_SZ = (size_t)1024 * 2816 * 2;
constexpr size_t W_IN0 = W_DN + 4 * W_DN_SZ;
constexpr size_t W_OUT0 = W_IN0 + (size_t)3072 * 1024 * 2;
constexpr size_t W_IN1 = W_OUT0 + (size_t)1024 * 1024 * 2;
constexpr size_t W_QUP = W_IN1 + (size_t)768 * 1024 * 2;
constexpr size_t W_KVUP = W_QUP + (size_t)1536 * 384 * 2;
constexpr size_t W_OUT1 = W_KVUP + (size_t)2048 * 256 * 2;
constexpr size_t WS_XB = W_OUT1 + (size_t)1024 * 1024 * 2;
constexpr size_t WS_SSP = WS_XB + (size_t)MT * D * 2;
constexpr size_t WS_SSC = WS_SSP + (size_t)MT * 16 * 4;
constexpr size_t WS_ROPE = WS_SSC + (size_t)MT * 24 * 4;
constexpr size_t WS_SSPS = WS_ROPE + (size_t)2048 * 16 * 8;
constexpr size_t WS_SSCS = WS_SSPS + (size_t)TS * 64 * 4;
constexpr size_t WS_M = al256(WS_SSCS + (size_t)TS * 40 * 4);
constexpr size_t WS_ACT = WS_M;
constexpr size_t QKV_SZ = (size_t)MT * 512 * 2;
constexpr size_t WS_O = WS_M;
constexpr size_t WS_QA = WS_O + (size_t)MT * D * 2, WS_KA = WS_QA + QKV_SZ, WS_VA = WS_KA + QKV_SZ, WS_QB = WS_VA + QKV_SZ, WS_KB = WS_QB + QKV_SZ, WS_VB = WS_KB + QKV_SZ;
constexpr size_t WS_KAS = WS_VB + QKV_SZ, KAS_SZ = (size_t)NB * KA_ROWS * 512 * 2, WS_VAS = WS_KAS + KAS_SZ;
constexpr size_t WS_KBS = WS_VAS + KAS_SZ, KBS_SZ = (size_t)NB * KB_ROWS * 512 * 2, WS_VBS = WS_KBS + KBS_SZ;
constexpr size_t WS_OT1 = WS_VBS + KBS_SZ;
constexpr size_t WS_L0_END = WS_OT1 + QKV_SZ;
constexpr size_t WS_CQ = WS_M;
constexpr size_t WS_CKVN = WS_CQ + (size_t)MT * 384 * 2;
static_assert(WS_CKVN + (size_t)(MKV + 128) * 256 * 2 <= WS_M + (size_t)MT * D * 2, "cq|ckvn inside the O overlay");
constexpr size_t WS_KRB = WS_O + (size_t)MT * D * 2;
constexpr size_t WS_QC = al256(WS_KRB + (size_t)(MKV + 128) * 32 * 2);
constexpr size_t WS_KVC = WS_QC + (size_t)MT * 1536 * 2;
constexpr size_t WS_L1_END = WS_KVC + ((size_t)NB * 16 * SEQ * 128 + (size_t)NB * 16 * 1040 * 128 + 128 * 128) * 2;
constexpr size_t WS_END = WS_L1_END > WS_L0_END ? WS_L1_END : WS_L0_END;
constexpr int XCD_BAR_WORDS_C = 3456;
constexpr size_t WS_CTL = al256(WS_END), CTL_BYTES = 16384;
static_assert(WS_CTL + CTL_BYTES <= (size_t)512 * 1024 * 1024, "d_ws map exceeds 512 MiB");
static_assert(XCD_BAR_WORDS_C * 4 <= CTL_BYTES, "ctl");
static_assert(WS_ACT + (size_t)MT * FF * 2 <= WS_END, "act inside the mixer region");

constexpr int LDS_BYTES = 132096;

struct Params { const float* in[31]; float* out; unsigned char* ws; int ph_lo, ph_hi; };

__device__ __forceinline__ int opq_tid() { int t = threadIdx.x; asm volatile("" : "+v"(t)); return t; }
__device__ __forceinline__ int opq_bid() { int b = blockIdx.x; asm volatile("" : "+s"(b)); return b; }
__device__ __forceinline__ float fast_exp2(float x) { return __builtin_amdgcn_exp2f(x); }
__device__ __forceinline__ float fadd_s(float a, float b) { float r; asm("v_add_f32_e32 %0, %1, %2" : "=v"(r) : "v"(a), "v"(b)); return r; }
__device__ __forceinline__ float fsub_s(float a, float b) { float r; asm("v_sub_f32_e32 %0, %1, %2" : "=v"(r) : "v"(a), "v"(b)); return r; }
__device__ __forceinline__ float fmul_s(float a, float b) { float r; asm("v_mul_f32_e32 %0, %1, %2" : "=v"(r) : "v"(a), "v"(b)); return r; }
typedef float f32x2c __attribute__((ext_vector_type(2))); typedef __bf16 bf16x2c __attribute__((ext_vector_type(2)));
__device__ __forceinline__ unsigned cvtpk_c(float lo, float hi) { f32x2c v = {lo, hi}; bf16x2c b = __builtin_convertvector(v, bf16x2c); return __builtin_bit_cast(unsigned, b); }
__device__ __forceinline__ u32x4 pack8_c(const f32x4 a, const f32x4 b) {
    u32x4 w; w.x = cvtpk_c(a[0], a[1]); w.y = cvtpk_c(a[2], a[3]); w.z = cvtpk_c(b[0], b[1]); w.w = cvtpk_c(b[2], b[3]); return w;
}
__device__ __forceinline__ float max3f(float a, float b, float c) { float r; asm("v_max3_f32 %0, %1, %2, %3" : "=v"(r) : "v"(a), "v"(b), "v"(c)); return r; }
__device__ __forceinline__ float wave_sum(float v) {
#pragma unroll
    for (int o = 32; o > 0; o >>= 1) v += __shfl_xor(v, o);
    return v;
}
__device__ __forceinline__ float rs_from(const float* p, int n4, float inv_n) {
    float s = 0.f;
    for (int i = 0; i < n4; ++i) { const f32x4 v = *(const f32x4*)(p + 4 * i); s += (v[0] + v[1]) + (v[2] + v[3]); }
    return rsqrtf(s * inv_n + EPS);
}
__device__ __forceinline__ void unpack8(const u32x4 w, f32x4& a, f32x4& b) {
    a[0] = __uint_as_float(w.x << 16); a[1] = __uint_as_float(w.x & 0xffff0000u); a[2] = __uint_as_float(w.y << 16); a[3] = __uint_as_float(w.y & 0xffff0000u);
    b[0] = __uint_as_float(w.z << 16); b[1] = __uint_as_float(w.z & 0xffff0000u); b[2] = __uint_as_float(w.w << 16); b[3] = __uint_as_float(w.w & 0xffff0000u);
}
__device__ __forceinline__ void st_nt(float* p, const f32x4 v) { __builtin_nontemporal_store(v, (f32x4*)p); }
__device__ __forceinline__ f32x4 ld_nt(const float* p) { return __builtin_nontemporal_load((const f32x4*)p); }
__device__ __forceinline__ u32x4 pack8(const f32x4 a, const f32x4 b) {
    u32x4 w; w.x = cvt_pk_bf16(a[0], a[1]); w.y = cvt_pk_bf16(a[2], a[3]); w.z = cvt_pk_bf16(b[0], b[1]); w.w = cvt_pk_bf16(b[2], b[3]); return w;
}

typedef const f32x4 (&AccRef)[2][2][4][2];

struct EpiSwiglu { static constexpr int ID = 0;
    static constexpr bool PERM = true, AFTER_DRAIN = false;
    bf16_t* act; const float* ssp;
    __device__ __forceinline__ void operator()(AccRef acc, const pg8::Unit& u, int wr, int wc, int fr, int fq) const {
        const int row0 = u.pm * 256 + wr * 64 + fr, col0 = u.pn * 128 + wc * 32 + 8 * fq;
#pragma unroll
        for (int ai = 0; ai < 2; ++ai)
#pragma unroll
            for (int m = 0; m < 4; ++m) {
                const int row = row0 + ai * 128 + m * 16;
                const float rs = rs_from(ssp + (size_t)row * 16, 4, 1.0f / 1024.0f);
                f32x4 o[2];
#pragma unroll
                for (int n = 0; n < 2; ++n)
#pragma unroll
                    for (int j = 0; j < 4; ++j) {
                        const float g = acc[ai][0][m][n][j] * rs, up = acc[ai][1][m][n][j] * rs;
                        o[n][j] = g * __builtin_amdgcn_rcpf(1.0f + __expf(-g)) * up;
                    }
                *(u32x4*)(act + (size_t)row * FF + col0) = pack8(o[0], o[1]);
            }
    }
};

struct EpiResid { static constexpr int ID = 1;
    static constexpr bool PERM = true, AFTER_DRAIN = false;
    float* x; bf16_t* xb; float* ssp; float alpha;
    __device__ __forceinline__ void operator()(AccRef acc, const pg8::Unit& u, int wr, int wc, int fr, int fq) const {
        const int row0 = u.pm * 256 + wr * 64 + fr, col0 = u.pn * 256 + wc * 32 + 8 * fq;
#pragma unroll
        for (int ai = 0; ai < 2; ++ai)
#pragma unroll
            for (int m = 0; m < 4; ++m) {
                const int row = row0 + ai * 128 + m * 16; float ss = 0.f;
#pragma unroll
                for (int bj = 0; bj < 2; ++bj) {
                    bf16_t* xp = xb + (size_t)row * D + col0 + bj * 128;
                    f32x4 a, b; unpack8(*(const u32x4*)xp, a, b);
                    a += acc[ai][bj][m][0] * alpha; b += acc[ai][bj][m][1] * alpha;
                    *(u32x4*)xp = pack8(a, b);
                    ss += (a[0] * a[0] + a[1] * a[1]) + (a[2] * a[2] + a[3] * a[3]) + (b[0] * b[0] + b[1] * b[1]) + (b[2] * b[2] + b[3] * b[3]);
                }
                ss += __shfl_xor(ss, 16); ss += __shfl_xor(ss, 32);
                if (fq == 0) ssp[(size_t)row * 16 + u.pn * 4 + wc] = ss;
            }
    }
};

struct EpiIn0 { static constexpr int ID = 2;
    static constexpr bool PERM = true, AFTER_DRAIN = false;
    const float* ssp; unsigned char* ws; float* out;
    __device__ __forceinline__ void operator()(AccRef acc, const pg8::Unit& u, int wr, int wc, int fr, int fq) const {
        const int sec = u.pn >> 1;
        const int row0 = u.pm * 256 + wr * 64 + fr, cs0 = (u.pn & 1) * 256 + wc * 32 + 8 * fq;
        const bool sample = (u.pm == 128);
        bf16_t* tok = (bf16_t*)(ws + WS_QA + (size_t)sec * QKV_SZ);
        const float qs = (sec == 0 || sec == 3) ? QS_AB : 1.0f;
#pragma unroll
        for (int ai = 0; ai < 2; ++ai)
#pragma unroll
            for (int m = 0; m < 4; ++m) {
                const int row = row0 + ai * 128 + m * 16;
                const float rs = rs_from(ssp + (size_t)row * 16, 4, 1.0f / 1024.0f);
                const float sc = rs * qs;
#pragma unroll
                for (int bj = 0; bj < 2; ++bj) {
                    const int cs = cs0 + bj * 128;
                    const f32x4 a = acc[ai][bj][m][0] * sc, b = acc[ai][bj][m][1] * sc;
                    const u32x4 w = pack8(a, b);
                    *(u32x4*)(tok + (size_t)row * 512 + cs) = w;
                    if (sec == 0 || sec == 3) continue;
                    float* fo = nullptr;
                    if (!sample) {
                        const int b_ = row >> 11, t = row & 2047;
                        if (sec == 1 || sec == 2) { if ((u.pm & 7) >= 6) fo = out + (sec == 1 ? O_PAK : O_PAV) + ((size_t)b_ * 512 + (t - 1536)) * 512 + cs; }
                        else fo = out + (sec == 4 ? O_PBK : O_PBV) + (size_t)row * 512 + cs;
                    } else {
                        const int sr = row - TP, b_ = sr >> 4, t = sr & 15;
                        const size_t so = (sec == 1) ? O_SAK : (sec == 2) ? O_SAV : (sec == 4) ? O_SBK : O_SBV;
                        fo = out + so + (size_t)sr * 512 + cs;
                        bf16_t* cat = (sec == 1) ? (bf16_t*)(ws + WS_KAS) + ((size_t)b_ * KA_ROWS + 512 + t) * 512
                                    : (sec == 2) ? (bf16_t*)(ws + WS_VAS) + ((size_t)b_ * KA_ROWS + 512 + t) * 512
                                    : (sec == 4) ? (bf16_t*)(ws + WS_KBS) + ((size_t)b_ * KB_ROWS + 1024 + t) * 512
                                                 : (bf16_t*)(ws + WS_VBS) + ((size_t)b_ * KB_ROWS + 1024 + t) * 512;
                        *(u32x4*)(cat + cs) = w;
                    }
                    if (fo) { st_nt(fo, a); st_nt(fo + 4, b); }
                }
            }
    }
};

struct EpiIn1 { static constexpr int ID = 3;
    static constexpr bool PERM = true, AFTER_DRAIN = false;
    const float* ssp; unsigned char* ws; float* out;
    __device__ __forceinline__ void operator()(AccRef acc, const pg8::Unit& u, int wr, int wc, int fr, int fq) const {
        const int row0 = u.pm * 256 + wr * 64 + fr;
        const bool sample = (u.pm == 128);
        bf16_t* cq = (bf16_t*)(ws + WS_CQ); float* ssc = (float*)(ws + WS_SSC);
#pragma unroll
        for (int ai = 0; ai < 2; ++ai)
#pragma unroll
            for (int m = 0; m < 4; ++m) {
                const int row = row0 + ai * 128 + m * 16;
                const float rs = rs_from(ssp + (size_t)row * 16, 4, 1.0f / 1024.0f);
#pragma unroll
                for (int bj = 0; bj < 2; ++bj) {
                    const int c = u.pn * 256 + bj * 128 + wc * 32 + 8 * fq;
                    const f32x4 a = acc[ai][bj][m][0] * rs, b = acc[ai][bj][m][1] * rs;
                    float ss = (a[0] * a[0] + a[1] * a[1]) + (a[2] * a[2] + a[3] * a[3]) + (b[0] * b[0] + b[1] * b[1]) + (b[2] * b[2] + b[3] * b[3]);
                    ss += __shfl_xor(ss, 16); ss += __shfl_xor(ss, 32);
                    const int part = u.pn * 2 + bj;
                    if (part < 5 && fq == 0) ssc[(size_t)row * 24 + part * 4 + wc] = ss;
                    if (part < 3) { *(u32x4*)(cq + (size_t)row * 384 + c) = pack8(a, b); }
                    else if (part < 5) {
                        float* fo = sample ? out + O_SCKV + (size_t)(row - TP) * 256 + (c - 384) : out + O_PCKV + (size_t)row * 256 + (c - 384);
                        *(f32x4*)fo = a; *(f32x4*)(fo + 4) = b;
                    } else if (wc == 0) {
                        float* fo = sample ? out + O_SCKR + (size_t)(row - TP) * 32 + (c - 640) : out + O_PCKR + (size_t)row * 32 + (c - 640);
                        *(f32x4*)fo = a; *(f32x4*)(fo + 4) = b;
                    }
                }
            }
    }
};

struct EpiQup { static constexpr int ID = 4;
    static constexpr bool PERM = true, AFTER_DRAIN = false;
    unsigned char* ws;
    __device__ __forceinline__ void operator()(AccRef acc, const pg8::Unit& u, int wr, int wc, int fr, int fq) const {
        const int row0 = u.pm * 256 + wr * 64 + fr;
        const float* ssc = (const float*)(ws + WS_SSC); bf16_t* qc = (bf16_t*)(ws + WS_QC); const float* rope = (const float*)(ws + WS_ROPE);
#pragma unroll
        for (int ai = 0; ai < 2; ++ai)
#pragma unroll
            for (int m = 0; m < 4; ++m) {
                const int row = row0 + ai * 128 + m * 16;
                const float rs = rs_from(ssc + (size_t)row * 24, 3, 1.0f / 384.0f) * QS_C;
                const int pos = row < TP ? (row & 2047) : PAST + ((row - TP) & 15);
#pragma unroll
                for (int bj = 0; bj < 2; ++bj) {
                    const int c = u.pn * 256 + bj * 128 + wc * 32 + 8 * fq;
                    const int o = c % 96;
                    f32x4 a = acc[ai][bj][m][0] * rs, b = acc[ai][bj][m][1] * rs;
                    if (o >= 64) {
                        const int i0 = (o - 64) >> 1;
                        const f32x4 cs0 = *(const f32x4*)(rope + ((size_t)pos * 16 + i0) * 2), cs1 = *(const f32x4*)(rope + ((size_t)pos * 16 + i0 + 2) * 2);
                        f32x4 a2, b2;
                        a2[0] = a[0] * cs0[0] - a[1] * cs0[1]; a2[1] = a[0] * cs0[1] + a[1] * cs0[0];
                        a2[2] = a[2] * cs0[2] - a[3] * cs0[3]; a2[3] = a[2] * cs0[3] + a[3] * cs0[2];
                        b2[0] = b[0] * cs1[0] - b[1] * cs1[1]; b2[1] = b[0] * cs1[1] + b[1] * cs1[0];
                        b2[2] = b[2] * cs1[2] - b[3] * cs1[3]; b2[3] = b[2] * cs1[3] + b[3] * cs1[2];
                        a = a2; b = b2;
                    }
                    *(u32x4*)(qc + (size_t)row * 1536 + c) = pack8(a, b);
                }
            }
    }
};

constexpr int KC_ROWS = 1040;
constexpr size_t KVC_S_OFF = (size_t)NB * 16 * SEQ * 128;
struct EpiKvHead { static constexpr int ID = 6;
    static constexpr bool PERM = true, AFTER_DRAIN = false;
    bf16_t* O;
    __device__ __forceinline__ void operator()(AccRef acc, const pg8::Unit& u, int wr, int wc, int fr, int fq) const {
        const int row0 = u.pm * 256 + wr * 64 + fr, col0 = u.pn * 256 + wc * 32 + 8 * fq;
        asm volatile("s_nop 15" ::: "memory");
#pragma unroll
        for (int ai = 0; ai < 2; ++ai)
#pragma unroll
            for (int m = 0; m < 4; ++m) {
                const int row = row0 + ai * 128 + m * 16; size_t base; long stride;
                if (row < TP) { base = ((size_t)(row >> 11) * 16 * SEQ + (row & 2047)) * 128; stride = (long)SEQ * 128; }
                else { const int sr = row - TP, b_ = sr / (PAST + NEW), pos = sr - b_ * (PAST + NEW); base = KVC_S_OFF + ((size_t)b_ * 16 * KC_ROWS + pos) * 128; stride = (long)KC_ROWS * 128; }
#pragma unroll
                for (int bj = 0; bj < 2; ++bj) { const int c = col0 + bj * 128;
                    *(u32x4*)(O + base + (size_t)(c >> 7) * stride + (c & 127)) = pack8_c(acc[ai][bj][m][0], acc[ai][bj][m][1]); }
            }
    }
};
struct EpiPlain { static constexpr int ID = 5;
    static constexpr bool PERM = true, AFTER_DRAIN = false;
    bf16_t* O; int ldc;
    __device__ __forceinline__ void operator()(AccRef acc, const pg8::Unit& u, int wr, int wc, int fr, int fq) const {
        const int row0 = u.pm * 256 + wr * 64 + fr, col0 = u.pn * 256 + wc * 32 + 8 * fq;
#pragma unroll
        for (int ai = 0; ai < 2; ++ai)
#pragma unroll
            for (int m = 0; m < 4; ++m)
#pragma unroll
                for (int bj = 0; bj < 2; ++bj)
                    *(u32x4*)(O + (size_t)(row0 + ai * 128 + m * 16) * ldc + col0 + bj * 128) = pack8_c(acc[ai][bj][m][0], acc[ai][bj][m][1]);
    }
};

template <class Epi> __device__ __forceinline__ void run_gemm(LAS unsigned char* lds, const bf16_t* A, const bf16_t* Bt, int M, int N, int K, const Epi& E) {
    asm volatile("" : "+s"(K));
    pg8::Gemm g{A, Bt, M, N, K}; pg8::StaticOrder S; S.init(M, N, (int)gridDim.x, (int)blockIdx.x);
#ifdef ONLY_G
    if constexpr (Epi::ID != ONLY_G) return;
#endif
#ifndef DIS_G
    pg8::gemm_phase<Epi, pg8::StaticOrder, true, true>(lds, g, S, E);
#endif
}


template <int NG, int UNR, class Epi, int KS = 1> __device__ __forceinline__ void skinny_gemm(const bf16_t* A, const bf16_t* Bt, int K, int ngroups, const Epi& E, int bshift = 0, LAS unsigned char* lds = nullptr) {
    const int tid = opq_tid(), lane = tid & 63, w = tid >> 6, rr = lane & 15, kq = lane >> 4;
    const int rg = KS == 2 ? (w & 3) : w, kh = KS == 2 ? (w >> 2) : 0, KL = K / KS;
    for (int u = (opq_bid() + (int)gridDim.x - bshift) % (int)gridDim.x; u < 2 * KS * ngroups; u += gridDim.x) {
        const int hv = u & (2 * KS - 1), cg = u / (2 * KS), srow = hv * (128 / KS) + rg * 16 + rr;
        const bf16_t* ap = A + (size_t)srow * K + kh * KL + 8 * kq;
        const bf16_t* bp[NG]; f32x4 acc[NG];
#pragma unroll
        for (int g = 0; g < NG; ++g) { bp[g] = Bt + (size_t)(Epi::brow(cg, g) + rr) * K + kh * KL + 8 * kq; acc[g] = (f32x4){0.f, 0.f, 0.f, 0.f}; }
        bf16x8 a0[UNR], a1[UNR], b0[NG][UNR], b1[NG][UNR];
#define SK_LOAD(AR, BR, k0) do { _Pragma("unroll") for (int i = 0; i < UNR; ++i) { AR[i] = *(const bf16x8*)(ap + (k0) + 32 * i); \
            _Pragma("unroll") for (int g = 0; g < NG; ++g) BR[g][i] = *(const bf16x8*)(bp[g] + (k0) + 32 * i); } } while (0)
#define SK_MMA(AR, BR) do { _Pragma("unroll") for (int i = 0; i < UNR; ++i) _Pragma("unroll") for (int g = 0; g < NG; ++g) acc[g] = __builtin_amdgcn_mfma_f32_16x16x32_bf16(BR[g][i], AR[i], acc[g], 0, 0, 0); } while (0)
        SK_LOAD(a0, b0, 0);
        for (int k = 0; k < KL; k += 64 * UNR) {
            SK_LOAD(a1, b1, k + 32 * UNR);
            SK_MMA(a0, b0);
            if (k + 64 * UNR < KL) SK_LOAD(a0, b0, k + 64 * UNR);
            SK_MMA(a1, b1);
        }
#undef SK_LOAD
#undef SK_MMA
        if constexpr (KS == 2) {
            LAS f32x4* xch = (LAS f32x4*)lds;
            if (kh == 1) xch[rg * 64 + lane] = acc[0] + (f32x4){0.f, 0.f, 0.f, 0.f};
            __syncthreads();
            if (kh == 0) { acc[0] += xch[rg * 64 + lane]; E(acc, srow, cg, kq); }
            __syncthreads();
        } else E(acc, srow, cg, kq);
    }
}
__device__ __forceinline__ float rs_sample(const float* ssps, int srow) { return rs_from(ssps + (size_t)srow * 64, 16, 1.0f / 1024.0f); }

struct SkSwiglu { static __device__ __forceinline__ int brow(int cg, int g) { return 256 * (cg >> 3) + 16 * (cg & 7) + 128 * g; }
    bf16_t* act; const float* ssps;
    __device__ __forceinline__ void operator()(const f32x4 (&acc)[2], int srow, int cg, int kq) const {
        const float rs = rs_sample(ssps, srow); f32x4 o;
#pragma unroll
        for (int j = 0; j < 4; ++j) { const float g = acc[0][j] * rs, up = acc[1][j] * rs; o[j] = g * __builtin_amdgcn_rcpf(1.0f + __expf(-g)) * up; }
        u32x2 w; w.x = cvt_pk_bf16(o[0], o[1]); w.y = cvt_pk_bf16(o[2], o[3]);
        *(u32x2*)(act + (size_t)(TP + srow) * FF + cg * 16 + 4 * kq) = w;
    }
};
struct SkSwiglu4 { static __device__ __forceinline__ int brow(int cgp, int g) { const int cg = 2 * cgp + (g >> 1); return 256 * (cg >> 3) + 16 * (cg & 7) + 128 * (g & 1); }
    bf16_t* act; const float* ssps;
    __device__ __forceinline__ void operator()(const f32x4 (&acc)[4], int srow, int cgp, int kq) const {
        const float rs = rs_sample(ssps, srow);
#pragma unroll
        for (int q = 0; q < 2; ++q) { f32x4 o;
#pragma unroll
            for (int j = 0; j < 4; ++j) { const float g = acc[2 * q][j] * rs, up = acc[2 * q + 1][j] * rs; o[j] = g * __builtin_amdgcn_rcpf(1.0f + __expf(-g)) * up; }
            u32x2 w; w.x = cvt_pk_bf16(o[0], o[1]); w.y = cvt_pk_bf16(o[2], o[3]);
            *(u32x2*)(act + (size_t)(TP + srow) * FF + (2 * cgp + q) * 16 + 4 * kq) = w; }
    }
};
struct SkResid { static __device__ __forceinline__ int brow(int cg, int) { return 16 * cg; }
    float* x; bf16_t* xb; float* ssps; float alpha;
    __device__ __forceinline__ void operator()(const f32x4 (&acc)[1], int srow, int cg, int kq) const {
        bf16_t* xp = xb + (size_t)(TP + srow) * D + cg * 16 + 4 * kq;
        const u32x2 w0 = *(const u32x2*)xp; f32x4 a;
        a[0] = __uint_as_float(w0.x << 16); a[1] = __uint_as_float(w0.x & 0xffff0000u); a[2] = __uint_as_float(w0.y << 16); a[3] = __uint_as_float(w0.y & 0xffff0000u);
        a += acc[0] * alpha;
        u32x2 w; w.x = cvt_pk_bf16(a[0], a[1]); w.y = cvt_pk_bf16(a[2], a[3]);
        *(u32x2*)xp = w;
        float ss = (a[0] * a[0] + a[1] * a[1]) + (a[2] * a[2] + a[3] * a[3]);
        ss += __shfl_xor(ss, 16); ss += __shfl_xor(ss, 32);
        if (kq == 0) ssps[(size_t)srow * 64 + cg] = ss;
    }
};
struct SkIn0 { static __device__ __forceinline__ int brow(int cg, int) { return 16 * cg; }
    const float* ssps; unsigned char* ws; float* out;
    __device__ __forceinline__ void operator()(const f32x4 (&acc)[1], int srow, int cg, int kq) const {
        const int sec = cg >> 5, cs = (cg & 31) * 16 + 4 * kq, b_ = srow >> 4, t = srow & 15;
        const float sc = rs_sample(ssps, srow) * ((sec == 0 || sec == 3) ? QS_AB : 1.0f);
        const f32x4 a = acc[0] * sc;
        u32x2 w; w.x = cvt_pk_bf16(a[0], a[1]); w.y = cvt_pk_bf16(a[2], a[3]);
        *(u32x2*)((bf16_t*)(ws + WS_QA + (size_t)sec * QKV_SZ) + (size_t)(TP + srow) * 512 + cs) = w;
        if (sec == 0 || sec == 3) return;
        const size_t so = (sec == 1) ? O_SAK : (sec == 2) ? O_SAV : (sec == 4) ? O_SBK : O_SBV;
        *(f32x4*)(out + so + (size_t)srow * 512 + cs) = a;
        bf16_t* cat = (sec == 1) ? (bf16_t*)(ws + WS_KAS) + ((size_t)b_ * KA_ROWS + 512 + t) * 512
                    : (sec == 2) ? (bf16_t*)(ws + WS_VAS) + ((size_t)b_ * KA_ROWS + 512 + t) * 512
                    : (sec == 4) ? (bf16_t*)(ws + WS_KBS) + ((size_t)b_ * KB_ROWS + 1024 + t) * 512
                                 : (bf16_t*)(ws + WS_VBS) + ((size_t)b_ * KB_ROWS + 1024 + t) * 512;
        *(u32x2*)(cat + cs) = w;
    }
};
struct SkIn1 { static __device__ __forceinline__ int brow(int cg, int) { return 16 * cg; }
    const float* ssps; unsigned char* ws; float* out;
    __device__ __forceinline__ void operator()(const f32x4 (&acc)[1], int srow, int cg, int kq) const {
        const f32x4 a = acc[0] * rs_sample(ssps, srow);
        float ss = (a[0] * a[0] + a[1] * a[1]) + (a[2] * a[2] + a[3] * a[3]);
        ss += __shfl_xor(ss, 16); ss += __shfl_xor(ss, 32);
        if (cg < 40 && kq == 0) ((float*)(ws + WS_SSCS))[(size_t)srow * 40 + cg] = ss;
        const int c = cg * 16 + 4 * kq;
        if (cg < 24) { u32x2 w; w.x = cvt_pk_bf16(a[0], a[1]); w.y = cvt_pk_bf16(a[2], a[3]); *(u32x2*)((bf16_t*)(ws + WS_CQ) + (size_t)(TP + srow) * 384 + c) = w; }
        else if (cg < 40) *(f32x4*)(out + O_SCKV + (size_t)srow * 256 + (c - 384)) = a;
        else *(f32x4*)(out + O_SCKR + (size_t)srow * 32 + (c - 640)) = a;
    }
};
struct SkPlain { static __device__ __forceinline__ int brow(int cg, int) { return 16 * cg; }
    bf16_t* O; int ldc;
    __device__ __forceinline__ void operator()(const f32x4 (&acc)[1], int srow, int cg, int kq) const {
        u32x2 w; w.x = cvt_pk_bf16(acc[0][0], acc[0][1]); w.y = cvt_pk_bf16(acc[0][2], acc[0][3]);
        *(u32x2*)(O + (size_t)srow * ldc + cg * 16 + 4 * kq) = w;
    }
};
struct SkKvHead { static __device__ __forceinline__ int brow(int cg, int) { return 16 * cg; }
    bf16_t* O;
    __device__ __forceinline__ void operator()(const f32x4 (&acc)[1], int srow, int cg, int kq) const {
        const int sr = (MKV - 256 - TP) + srow, b_ = sr / (PAST + NEW), pos = sr - b_ * (PAST + NEW), c = cg * 16 + 4 * kq;
        u32x2 w; w.x = cvtpk_c(acc[0][0], acc[0][1]); w.y = cvtpk_c(acc[0][2], acc[0][3]);
        *(u32x2*)(O + KVC_S_OFF + (((size_t)b_ * 16 + (c >> 7)) * KC_ROWS + pos) * 128 + (c & 127)) = w;
    }
};
struct SkQup { static __device__ __forceinline__ int brow(int cg, int) { return 16 * cg; }
    unsigned char* ws;
    __device__ __forceinline__ void operator()(const f32x4 (&acc)[1], int srow, int cg, int kq) const {
        const float rs = rs_from((const float*)(ws + WS_SSCS) + (size_t)srow * 40, 6, 1.0f / 384.0f) * QS_C;
        const int c = cg * 16 + 4 * kq, o = c % 96, pos = PAST + (srow & 15);
        f32x4 a = acc[0] * rs;
        if (o >= 64) {
            const int i0 = (o - 64) >> 1;
            const f32x4 cs0 = *(const f32x4*)((const float*)(ws + WS_ROPE) + ((size_t)pos * 16 + i0) * 2);
            f32x4 a2; a2[0] = a[0] * cs0[0] - a[1] * cs0[1]; a2[1] = a[0] * cs0[1] + a[1] * cs0[0]; a2[2] = a[2] * cs0[2] - a[3] * cs0[3]; a2[3] = a[2] * cs0[3] + a[3] * cs0[2];
            a = a2;
        }
        u32x2 w; w.x = cvt_pk_bf16(a[0], a[1]); w.y = cvt_pk_bf16(a[2], a[3]);
        *(u32x2*)((bf16_t*)(ws + WS_QC) + (size_t)(TP + srow) * 1536 + c) = w;
    }
};

__device__ __forceinline__ void convert_weight(LAS unsigned char* lds, const float* W, bf16_t* Bt, int K, int Nsrc, int Ndst, const float* gain, int mode) {
    LAS float* tile = (LAS float*)lds;
    const int tid = opq_tid(), nkt = K / 64, nnt = Ndst / 64;
    for (int t = opq_bid(); t < nkt * nnt; t += gridDim.x) {
        const int k0 = (t % nkt) * 64, n0 = (t / nkt) * 64;
#pragma unroll
        for (int i = 0; i < 8; ++i) {
            const int e = tid + i * 512, kk = e >> 6, nn = e & 63, np = n0 + nn; int n;
            if (mode == 1) { const int pn = np >> 8, bj = (np >> 7) & 1, c = np & 127; n = bj * FF + pn * 128 + c; }
            else if (mode == 2) { const int h = np / 96, o = np % 96; n = o < 64 ? np : h * 96 + 64 + ((o - 64) & 1) * 16 + ((o - 64) >> 1); }
            else n = np;
            float v = 0.f;
            if (n < Nsrc) { v = W[(size_t)(k0 + kk) * Nsrc + n]; if (gain) v *= gain[k0 + kk]; }
            tile[kk * 65 + nn] = v;
        }
        __syncthreads();
#pragma unroll
        for (int i = 0; i < 4; ++i) {
            const int e = tid + i * 512, nn = e >> 5, kp = e & 31;
            *(unsigned*)(Bt + (size_t)(n0 + nn) * K + k0 + 2 * kp) = cvt_pk_bf16(tile[(2 * kp) * 65 + nn], tile[(2 * kp + 1) * 65 + nn]);
        }
        __syncthreads();
    }
}


__device__ __forceinline__ void convert_weight_v4(LAS unsigned char* lds, const float* W, bf16_t* Bt, int K, int Nsrc, int Ndst, const float* gain, int mode) {
    LAS float* tile = (LAS float*)lds;
    const int tid = opq_tid(), nkt = K / 64, nnt = Ndst / 256;
    for (int t = opq_bid(); t < nkt * nnt; t += gridDim.x) {
        const int k0 = (t % nkt) * 64, pn = t / nkt, n0 = pn * 256;
        f32x4 v[8];
#pragma unroll
        for (int i = 0; i < 8; ++i) {
            const int e = tid + i * 512, kk = e >> 6, n4 = e & 63;
            const int n = (mode == 1) ? (n4 >> 5) * FF + pn * 128 + (n4 & 31) * 4 : n0 + n4 * 4;
            v[i] = (f32x4){0.f, 0.f, 0.f, 0.f};
            if (n < Nsrc) v[i] = ld_nt(W + (size_t)(k0 + kk) * Nsrc + n);
        }
#pragma unroll
        for (int i = 0; i < 8; ++i) {
            const int e = tid + i * 512, kk = e >> 6, n4 = e & 63;
            const float g = gain ? gain[k0 + kk] : 1.0f;
#pragma unroll
            for (int j = 0; j < 4; ++j) tile[kk * 257 + n4 * 4 + j] = v[i][j] * g;
        }
        __syncthreads();
#pragma unroll
        for (int i = 0; i < 8; ++i) {
            const int e = tid + i * 512, nn = e >> 4, kq = e & 15;
            u32x2 w; w.x = cvt_pk_bf16(tile[(4 * kq) * 257 + nn], tile[(4 * kq + 1) * 257 + nn]); w.y = cvt_pk_bf16(tile[(4 * kq + 2) * 257 + nn], tile[(4 * kq + 3) * 257 + nn]);
            *(u32x2*)(Bt + (size_t)(n0 + nn) * K + k0 + 4 * kq) = w;
        }
        __syncthreads();
    }
}

__device__ __forceinline__ void convert_rows(const float* src, bf16_t* dst, int R, int W, int per, int stride, int off, int vb = -1, int nb = 0) {
    if (vb < 0) { vb = opq_bid(); nb = (int)gridDim.x; }
    const int cpr = W / 8; const long total = (long)R * cpr, step = (long)nb * 512;
    for (long c0 = (long)vb * 512 + opq_tid(); c0 < total; c0 += 4 * step) {
        f32x4 a[4], b[4];
#pragma unroll
        for (int q = 0; q < 4; ++q) { const long c = c0 + q * step; if (c < total) { const long r = c / cpr; const int c8 = (int)(c % cpr);
            a[q] = ld_nt(src + (size_t)r * W + c8 * 8); b[q] = ld_nt(src + (size_t)r * W + c8 * 8 + 4); } }
#pragma unroll
        for (int q = 0; q < 4; ++q) { const long c = c0 + q * step; if (c < total) { const int r = (int)(c / cpr), c8 = (int)(c % cpr);
            const size_t dr = (size_t)(r / per) * stride + off + (r % per);
            *(u32x4*)(dst + dr * W + c8 * 8) = pack8(a[q], b[q]); } }
    }
}

__device__ __forceinline__ void prologue(LAS unsigned char* lds, const Params& P) {
    unsigned char* ws = P.ws; const float* const* in = P.in;
    const int tid = opq_tid(), lane = tid & 63, gw = opq_bid() * 8 + (tid >> 6), nw = gridDim.x * 8;
    for (int l = 0; l < 2; ++l) {
        convert_weight_v4(lds, in[10] + (size_t)l * D * 2 * FF, (bf16_t*)(ws + W_GU + (size_t)(l * 2 + 0) * W_GU_SZ), D, 2 * FF, 2 * FF, in[9] + l * D, 1);
        convert_weight_v4(lds, in[14] + (size_t)l * D * 2 * FF, (bf16_t*)(ws + W_GU + (size_t)(l * 2 + 1) * W_GU_SZ), D, 2 * FF, 2 * FF, in[13] + l * D, 1);
        convert_weight_v4(lds, in[11] + (size_t)l * FF * D, (bf16_t*)(ws + W_DN + (size_t)(l * 2 + 0) * W_DN_SZ), FF, D, D, nullptr, 0);
        convert_weight_v4(lds, in[15] + (size_t)l * FF * D, (bf16_t*)(ws + W_DN + (size_t)(l * 2 + 1) * W_DN_SZ), FF, D, D, nullptr, 0);
    }
    convert_weight_v4(lds, in[16], (bf16_t*)(ws + W_IN0), D, 3072, 3072, in[12], 0);
    convert_weight_v4(lds, in[23], (bf16_t*)(ws + W_OUT0), D, D, D, nullptr, 0);
    convert_weight_v4(lds, in[24], (bf16_t*)(ws + W_IN1), D, 672, 768, in[12] + D, 0);
    convert_weight(lds, in[27], (bf16_t*)(ws + W_QUP), 384, 1536, 1536, in[25], 2);
    convert_weight_v4(lds, in[28], (bf16_t*)(ws + W_KVUP), 256, 2048, 2048, nullptr, 0);
    convert_weight_v4(lds, in[29], (bf16_t*)(ws + W_OUT1), D, D, D, nullptr, 0);
    {
        bf16_t* xb = (bf16_t*)(ws + WS_XB); float* ssp = (float*)(ws + WS_SSP);
        for (int row0 = gw * 2; row0 < MT; row0 += nw * 2) {
            f32x4 a[2][2], b[2][2];
#pragma unroll
            for (int q = 0; q < 2; ++q) { const int row = row0 + q; const float* src = row < TP ? in[0] + (size_t)row * D : in[1] + (size_t)(row - TP) * D;
#pragma unroll
                for (int i = 0; i < 2; ++i) { const int c = (lane + i * 64) * 8; a[q][i] = ld_nt(src + c); b[q][i] = ld_nt(src + c + 4); } }
#pragma unroll
            for (int q = 0; q < 2; ++q) { const int row = row0 + q; float ss = 0.f;
#pragma unroll
                for (int i = 0; i < 2; ++i) { const int c = (lane + i * 64) * 8; const f32x4 av = a[q][i], bv = b[q][i];
                    *(u32x4*)(xb + (size_t)row * D + c) = pack8(av, bv);
                    ss += (av[0] * av[0] + av[1] * av[1]) + (av[2] * av[2] + av[3] * av[3]) + (bv[0] * bv[0] + bv[1] * bv[1]) + (bv[2] * bv[2] + bv[3] * bv[3]); }
                ss = wave_sum(ss);
                if (lane < 16) ssp[(size_t)row * 16 + lane] = lane == 0 ? ss : 0.f;
                if (row >= TP) ((float*)(ws + WS_SSPS))[(size_t)(row - TP) * 64 + lane] = lane == 0 ? ss : 0.f; }
        }
    }
    convert_rows(in[2], (bf16_t*)(ws + WS_KAS), NB * 512, 512, 512, KA_ROWS, 0);
    convert_rows(in[3], (bf16_t*)(ws + WS_VAS), NB * 512, 512, 512, KA_ROWS, 0);
    convert_rows(in[4], (bf16_t*)(ws + WS_KBS), NB * 1024, 512, 1024, KB_ROWS, 0);
    convert_rows(in[5], (bf16_t*)(ws + WS_VBS), NB * 1024, 512, 1024, KB_ROWS, 0);
    {
        float* rope = (float*)(ws + WS_ROPE);
        for (int e = opq_bid() * 512 + tid; e < 2048 * 16; e += gridDim.x * 512) {
            const int pos = e >> 4, i = e & 15;
            const float inv = expf(-(float)i * (9.210340371976184f / 16.0f));
            const float ang = (float)pos * inv;
            const float k = rintf(ang * 0.15915494309189535f);
            float r = fmaf(-k, 6.28125f, ang); r = fmaf(-k, 1.9353071795864769e-3f, r);
            rope[2 * e] = __cosf(r); rope[2 * e + 1] = __sinf(r);
        }
    }
}

__device__ __forceinline__ void prologue_l1(const Params& P, int vb, int nb) {
    unsigned char* ws = P.ws;
    convert_rows(P.in[6], (bf16_t*)(ws + WS_CKVN), NB * 1024, 256, 1024, PAST + NEW, TP, vb, nb);
    bf16_t* krb = (bf16_t*)(ws + WS_KRB); const float* src = P.in[7];
    for (long c = (long)vb * 512 + opq_tid(); c < (long)NB * 1024 * 4; c += (long)nb * 512) {
        const int r = (int)(c >> 2), c8 = (int)(c & 3);
        const f32x4 a = *(const f32x4*)(src + (size_t)r * 32 + c8 * 4), b = *(const f32x4*)(src + (size_t)r * 32 + 16 + c8 * 4);
        const size_t dr = (size_t)TP + (size_t)(r >> 10) * (PAST + NEW) + (r & 1023);
        u32x4 w; w.x = cvt_pk_bf16(a[0], b[0]); w.y = cvt_pk_bf16(a[1], b[1]); w.z = cvt_pk_bf16(a[2], b[2]); w.w = cvt_pk_bf16(a[3], b[3]);
        *(u32x4*)(krb + dr * 32 + c8 * 8) = w;
    }
}

__device__ __forceinline__ void thin_l1(const Params& P) {
    unsigned char* ws = P.ws;
    const int tid = opq_tid(), lane = tid & 63, gw = opq_bid() * 8 + (tid >> 6), nw = gridDim.x * 8;
    const float* ssc = (const float*)(ws + WS_SSC); const float* gkv = P.in[26]; const float* rope = (const float*)(ws + WS_ROPE);
    bf16_t* ckvn = (bf16_t*)(ws + WS_CKVN); bf16_t* krb = (bf16_t*)(ws + WS_KRB);
    const f32x4 g = *(const f32x4*)(gkv + lane * 4);
    for (int row = gw; row < MT; row += nw) {
        const bool sample = row >= TP; const int sr = row - TP;
        float* ckv = sample ? P.out + O_SCKV + (size_t)sr * 256 : P.out + O_PCKV + (size_t)row * 256;
        float* kr = sample ? P.out + O_SCKR + (size_t)sr * 32 : P.out + O_PCKR + (size_t)row * 32;
        const size_t dr = sample ? (size_t)TP + (size_t)(sr >> 4) * (PAST + NEW) + PAST + (sr & 15) : (size_t)row;
        const int pos = sample ? PAST + (sr & 15) : (row & 2047);
        const float rs = sample ? rs_from((const float*)(ws + WS_SSCS) + (size_t)sr * 40 + 24, 4, 1.0f / 256.0f) : rs_from(ssc + (size_t)row * 24 + 12, 2, 1.0f / 256.0f);
        f32x4 v = *(const f32x4*)(ckv + lane * 4); v = v * rs * g;
        *(f32x4*)(ckv + lane * 4) = v;
        u32x2 w; w.x = cvt_pk_bf16(v[0], v[1]); w.y = cvt_pk_bf16(v[2], v[3]);
        *(u32x2*)(ckvn + dr * 256 + lane * 4) = w;
        if (lane < 16) {
            const float x1 = kr[lane], x2 = kr[16 + lane];
            const float c = rope[((size_t)pos * 16 + lane) * 2], s = rope[((size_t)pos * 16 + lane) * 2 + 1];
            const float y1 = x1 * c - x2 * s, y2 = x1 * s + x2 * c;
            kr[lane] = y1; kr[16 + lane] = y2;
            *(unsigned*)(krb + dr * 32 + 2 * lane) = cvt_pk_bf16(y1, y2);
        }
    }
}

__device__ __forceinline__ void final_norm(const Params& P) {
    const int tid = opq_tid(), lane = tid & 63, gw = opq_bid() * 8 + (tid >> 6), nw = gridDim.x * 8;
    const float* ssp = (const float*)(P.ws + WS_SSP); const float* g = P.in[30]; float* x = P.out; const bf16_t* xbf = (const bf16_t*)(P.ws + WS_XB);
    for (int row = gw; row < MT; row += nw) {
        const float rs = row >= TP ? rs_sample((const float*)(P.ws + WS_SSPS), row - TP) : rs_from(ssp + (size_t)row * 16, 4, 1.0f / 1024.0f);
#pragma unroll
        for (int i = 0; i < 2; ++i) {
            const int c = (lane + i * 64) * 8;
            f32x4 a, b; unpack8(*(const u32x4*)(xbf + (size_t)row * D + c), a, b);
            const f32x4 g0 = *(const f32x4*)(g + c), g1 = *(const f32x4*)(g + c + 4);
            st_nt(x + (size_t)row * D + c, a * rs * g0); st_nt(x + (size_t)row * D + c + 4, b * rs * g1);
        }
    }
}

struct KVSrc { const bf16_t* k; long kp; const bf16_t* k2; long k2p; const bf16_t* v; long vp; };
typedef short v4i16_t __attribute__((ext_vector_type(4)));
__device__ __forceinline__ s16x4 vtr(const LAS unsigned char* p) { return __builtin_bit_cast(s16x4, __builtin_amdgcn_ds_read_tr16_b64_v4i16((LAS v4i16_t*)p)); }

constexpr int ATT_TAB = 0, ATT_BUF = 1024;

template <int DQK, int DV, bool BIAS, int TK>
__device__ __forceinline__ void flash_pass(LAS unsigned char* lds, const KVSrc& S, int uc0, int uc1, int wc0, int wc1, int nkeys,
                                           const bf16x8 (&qf)[DQK / 16], int qpos, int qpos_w0, int kpos0, f32x16 (&o)[DV / 32], float& m_run, float& l_run) {
    constexpr int KP = DQK * 2 + 16, VP = DV * 2 + 64, KBUF = TK * KP, VBUF = TK * VP, KCH = DQK / 8, VCH = DV / 8, NKI = TK * KCH / 512, NVI = TK * VCH / 512, NPB = TK / 32, NST = TK / 16;
    static_assert((TK == 64 || TK == 128) && TK * KCH % 512 == 0 && TK * VCH % 512 == 0 && ATT_BUF + 2 * (KBUF + VBUF) <= 131072, "attention tile geometry");
    const int tid = opq_tid(), lane = tid & 63, l31 = lane & 31, hi = lane >> 5;
    LAS unsigned char* kb0 = lds + ATT_BUF; LAS unsigned char* vb0 = lds + ATT_BUF + 2 * KBUF;
    const LAS float* tab = (const LAS float*)(lds + ATT_TAB);
    const int t0 = (uc0 * 64) / TK, t1 = (uc1 * 64 + TK - 1) / TK;
    if (t0 >= t1) return;
    const int klo = 64 * wc0, khi = (64 * wc1 < nkeys) ? 64 * wc1 : nkeys;
    const int w0 = klo / TK, w1 = khi > klo ? (khi + TK - 1) / TK : w0;
    u32x4 kreg[NKI], vreg[NVI];
#define ATT_LOAD(t) do { \
        _Pragma("unroll") for (int i = 0; i < NKI; ++i) { const int c = tid + i * 512; const int r = c / KCH, cc = c % KCH; const long kr = (long)(t) * TK + r; \
            const bf16_t* src = (DQK == 96 && cc >= 8) ? S.k2 + kr * S.k2p + (cc - 8) * 8 : S.k + kr * S.kp + cc * 8; kreg[i] = *(const u32x4*)src; } \
        _Pragma("unroll") for (int i = 0; i < NVI; ++i) { const int c = tid + i * 512; const int r = c / VCH, cc = c % VCH; vreg[i] = *(const u32x4*)(S.v + ((long)(t) * TK + r) * S.vp + cc * 8); } } while (0)
#define ATT_STORE(b) do { \
        _Pragma("unroll") for (int i = 0; i < NKI; ++i) { const int c = tid + i * 512; const int r = c / KCH, cc = c % KCH; *(LAS u32x4*)(kb0 + (b) * KBUF + r * KP + cc * 16) = kreg[i]; } \
        _Pragma("unroll") for (int i = 0; i < NVI; ++i) { const int c = tid + i * 512; const int r = c / VCH, cc = c % VCH; *(LAS u32x4*)(vb0 + (b) * VBUF + r * VP + cc * 16) = vreg[i]; } } while (0)
    ATT_LOAD(t0); ATT_STORE(0); __syncthreads();
    const bool young = __builtin_amdgcn_readfirstlane(tid) >= 256;
    if (young) __builtin_amdgcn_s_setprio(1);
    const int koff = l31 * KP + hi * 16;
    const int voff = (4 * hi + ((lane & 15) >> 2)) * VP + (16 * ((lane >> 4) & 1) + 4 * (lane & 3)) * 2;
    for (int t = t0; t < t1; ++t) {
        const int cur = (t - t0) & 1;
        ATT_LOAD((t + 1 < t1 ? t + 1 : t1 - 1));
        if (t >= w0 && t < w1) {
            const LAS unsigned char* kb = kb0 + cur * KBUF + koff; const LAS unsigned char* vb = vb0 + cur * VBUF + voff;
            f32x16 p[NPB];
#pragma unroll
            for (int q = 0; q < NPB; ++q)
#pragma unroll
                for (int r = 0; r < 16; ++r) p[q][r] = 0.f;
#pragma unroll
            for (int ks = 0; ks < DQK / 16; ++ks)
#pragma unroll
                for (int q = 0; q < NPB; ++q) {
                    const bf16x8 a = *(const LAS bf16x8*)(kb + q * 32 * KP + ks * 32);
                    p[q] = __builtin_amdgcn_mfma_f32_32x32x16_bf16(a, qf[ks], p[q], 0, 0, 0);
                }
            __builtin_amdgcn_sched_barrier(0);
            asm volatile("s_nop 15\n\ts_nop 15" ::: "memory");
            const int tk0 = t * TK;
            if (BIAS) {
                const int tkpos = kpos0 + tk0;
                if (qpos_w0 - (tkpos + TK - 64) >= 192) { const float c = tab[254];
#pragma unroll
                    for (int q = 0; q < NPB; ++q)
#pragma unroll
                        for (int r = 0; r < 16; ++r) p[q][r] += c; }
                else { const int base = qpos - (tkpos + 4 * hi) + 63;
#pragma unroll
                    for (int q = 0; q < NPB; ++q)
#pragma unroll
                        for (int r = 0; r < 16; ++r) { int i0 = base - ((r & 3) + 8 * (r >> 2)) - 32 * q; i0 = i0 > 254 ? 254 : i0; p[q][r] += tab[i0]; } }
            }
            if (tk0 < klo || tk0 + TK > khi) {
                asm volatile("" ::: "memory");
#pragma unroll
                for (int q = 0; q < NPB; ++q)
#pragma unroll
                    for (int r = 0; r < 16; ++r) { const int key = tk0 + 32 * q + 4 * hi + (r & 3) + 8 * (r >> 2); if (key < klo || key >= khi) p[q][r] = NEGBIG; }
            }
            float mxa = max3f(p[0][0], p[0][1], p[1][0]), mxb = max3f(p[0][2], p[0][3], p[1][1]); mxa = max3f(mxa, p[1][2], p[1][3]);
#pragma unroll
            for (int r = 4; r < 16; r += 4) { mxa = max3f(mxa, p[0][r], p[0][r + 1]); mxb = max3f(mxb, p[0][r + 2], p[0][r + 3]); mxa = max3f(mxa, p[1][r], p[1][r + 1]); mxb = max3f(mxb, p[1][r + 2], p[1][r + 3]); }
            if constexpr (NPB == 4) {
#pragma unroll
                for (int r = 0; r < 16; r += 4) { mxa = max3f(mxa, p[2][r], p[2][r + 1]); mxb = max3f(mxb, p[2][r + 2], p[2][r + 3]); mxa = max3f(mxa, p[3][r], p[3][r + 1]); mxb = max3f(mxb, p[3][r + 2], p[3][r + 3]); }
            }
            float mx = max3f(mxa, mxb, m_run);
            mx = max3f(mx, __shfl_xor(mx, 32), mx);
            const float mnew = mx, alpha = fast_exp2(m_run - mnew);
            const bool grew = __builtin_amdgcn_ballot_w64(mnew > m_run) != 0ull;
            m_run = mnew;
            typedef float f32x2v __attribute__((ext_vector_type(2)));
            const f32x2v mm = {mnew, mnew}; f32x2v sum2 = {0.f, 0.f};
#pragma unroll
            for (int q = 0; q < NPB; ++q)
#pragma unroll
                for (int r = 0; r < 16; r += 2) {
                    f32x2v a = (f32x2v){p[q][r], p[q][r + 1]} - mm;
                    a.x = fast_exp2(a.x); a.y = fast_exp2(a.y);
                    p[q][r] = a.x; p[q][r + 1] = a.y; sum2 += a;
                }
            const float sum = sum2.x + sum2.y;
            l_run = l_run * alpha + sum;
            if (grew) {
#pragma unroll
                for (int db = 0; db < DV / 32; ++db) o[db] *= alpha;
            }
            __builtin_amdgcn_sched_barrier(0);
            bf16x8 pf[NST];
#pragma unroll
            for (int s = 0; s < NST; ++s) {
                const int q = s >> 1, h8 = (s & 1) * 8; u32x4 w;
                w.x = cvtpk_c(p[q][h8 + 0], p[q][h8 + 1]); w.y = cvtpk_c(p[q][h8 + 2], p[q][h8 + 3]); w.z = cvtpk_c(p[q][h8 + 4], p[q][h8 + 5]); w.w = cvtpk_c(p[q][h8 + 6], p[q][h8 + 7]);
                pf[s] = __builtin_bit_cast(bf16x8, w);
            }
#pragma unroll
            for (int db = 0; db < DV / 32; ++db)
#pragma unroll
                for (int s = 0; s < NST; ++s) {
                    const s16x4 lo = vtr(vb + (16 * s) * VP + db * 64), hh = vtr(vb + (16 * s + 8) * VP + db * 64);
                    const bf16x8 vf = (bf16x8){lo[0], lo[1], lo[2], lo[3], hh[0], hh[1], hh[2], hh[3]};
                    o[db] = __builtin_amdgcn_mfma_f32_32x32x16_bf16(vf, pf[s], o[db], 0, 0, 0);
                    if ((s & 3) == 3) __builtin_amdgcn_sched_barrier(0);
                }
        }
        ATT_STORE(cur ^ 1);
#ifdef PROBE_STAGE2
        ATT_LOAD((t + 1 < t1 ? t + 1 : t1 - 1)); asm volatile("" ::: "memory"); ATT_STORE(cur ^ 1);
#endif
        __syncthreads();
    }
    if (young) __builtin_amdgcn_s_setprio(0);
#undef ATT_LOAD
#undef ATT_STORE
}

template <int NQF> __device__ __forceinline__ void load_q(bf16x8 (&qf)[NQF], const bf16_t* qrow, int hi) {
#pragma unroll
    for (int ks = 0; ks < NQF; ++ks) qf[ks] = *(const bf16x8*)(qrow + 16 * ks + 8 * hi);
}
template <int NDB> __device__ __forceinline__ void store_o(bf16_t* orow, const f32x16 (&o)[NDB], float inv, int hi, bool valid) {
    if (!valid) return;
#pragma unroll
    for (int db = 0; db < NDB; ++db)
#pragma unroll
        for (int g = 0; g < 4; ++g) {
            u32x2 w; w.x = cvt_pk_bf16(o[db][4 * g] * inv, o[db][4 * g + 1] * inv); w.y = cvt_pk_bf16(o[db][4 * g + 2] * inv, o[db][4 * g + 3] * inv);
            *(u32x2*)(orow + 32 * db + 8 * g + 4 * hi) = w;
        }
}

__device__ __forceinline__ int t5_bucket(int rel) {
    const int n = rel < 0 ? -rel : rel; int b;
    if (n < 8) b = n; else if (n < 12) b = 8; else if (n < 16) b = 9; else if (n < 23) b = 10; else if (n < 32) b = 11; else if (n < 46) b = 12; else if (n < 64) b = 13; else if (n < 91) b = 14; else b = 15;
    return b + (rel > 0 ? 16 : 0);
}

__device__ __forceinline__ void attn_a(LAS unsigned char* lds, const Params& P) {
    unsigned char* ws = P.ws; const int tid = opq_tid(), lane = tid & 63, w = tid >> 6, l31 = lane & 31, hi = lane >> 5;
    bf16_t* O = (bf16_t*)(ws + WS_O); const bf16_t* QA = (const bf16_t*)(ws + WS_QA);
    LAS float* tab = (LAS float*)(lds + ATT_TAB);
    for (int u0 = opq_bid(); u0 < 1024 + 256; u0 += gridDim.x) {
        if (u0 >= 1024 && (((u0 - 1024) >> 3) & 1) == 0) continue;
        const int u = u0 >= 1024 ? 1024 + (((u0 - 1024) >> 4) * 8 + ((u0 - 1024) & 7)) : u0;
        const bool sample = u >= 1024; int b, h, qb = 0;
        if (!sample) { const int r = u >> 8, c = u & 255, xc = c & 7, j = c >> 3; const int bh = xc * 16 + (j >> 1); qb = 2 * r + (j & 1); b = bh >> 3; h = bh & 7; }
        else { const int s = u - 1024; b = s >> 3; h = s & 7; }
        if (tid < 256) { int rel = tid - 63; rel = rel > 64 ? 64 : rel; tab[tid] = P.in[17][h * 129 + rel + 64] * LOG2E; }
        KVSrc S; int t0, t1, w0, w1, nkeys, qpos, qpos_w0, kpos0; long qrow; bool valid;
        if (!sample) {
            const size_t base = (size_t)b * SEQ * 512 + h * 64;
            S = KVSrc{(const bf16_t*)(ws + WS_KA) + base, 512, nullptr, 0, (const bf16_t*)(ws + WS_VA) + base, 512};
            const int c0 = qb * 4, cw = c0 + (w >> 1);
            t0 = c0 - 8 < 0 ? 0 : c0 - 8; t1 = c0 + 4; w0 = cw - 8 < 0 ? 0 : cw - 8; w1 = cw + 1; nkeys = SEQ;
            qpos_w0 = qb * 256 + (w >> 1) * 64; qpos = qb * 256 + w * 32 + l31; kpos0 = 0; qrow = (long)b * SEQ + qpos; valid = true;
        } else {
            const size_t base = (size_t)b * KA_ROWS * 512 + h * 64;
            S = KVSrc{(const bf16_t*)(ws + WS_KAS) + base, 512, nullptr, 0, (const bf16_t*)(ws + WS_VAS) + base, 512};
            t0 = 0; t1 = 9; w0 = 0; w1 = (w == 0) ? 9 : 0; nkeys = 512 + NEW;
            qpos_w0 = PAST; qpos = PAST + (l31 & 15); kpos0 = PAST - 512; qrow = (long)TP + b * NEW + (l31 & 15); valid = (w == 0) && l31 < 16;
        }
        bf16x8 qf[4]; load_q<4>(qf, QA + qrow * 512 + h * 64, hi);
        f32x16 o[2];
#pragma unroll
        for (int db = 0; db < 2; ++db)
#pragma unroll
            for (int r = 0; r < 16; ++r) o[db][r] = 0.f;
        float m_run = NEGBIG, l_run = 0.f;
        flash_pass<64, 64, true, 128>(lds, S, t0, t1, w0, w1, nkeys, qf, qpos, qpos_w0, kpos0, o, m_run, l_run);
        l_run += __shfl_xor(l_run, 32);
        store_o<2>(O + qrow * 1024 + h * 64, o, 1.0f / l_run, hi, valid);
    }
}

__device__ __forceinline__ float diff_lambda(const Params& P) {
    float d1 = 0.f, d2 = 0.f;
    for (int i = 0; i < 64; ++i) { d1 += P.in[18][i] * P.in[19][i]; d2 += P.in[20][i] * P.in[21][i]; }
    return expf(d1) - expf(d2) + 0.2f;
}
__device__ __forceinline__ void attn_b(LAS unsigned char* lds, const Params& P) {
    unsigned char* ws = P.ws; const int tid = opq_tid(), lane = tid & 63, w = tid >> 6, l31 = lane & 31, hi = lane >> 5;
    bf16_t* O = (bf16_t*)(ws + WS_O); bf16_t* OT1 = (bf16_t*)(ws + WS_OT1); const bf16_t* QB = (const bf16_t*)(ws + WS_QB);
    LAS float* tab = (LAS float*)(lds + ATT_TAB);
    for (int u0 = opq_bid(); u0 < 1024 + 256; u0 += gridDim.x) {
        if (u0 >= 1024 && (((u0 - 1024) >> 3) & 1) == 1) continue;
        const int u = u0 >= 1024 ? 1024 + (((u0 - 1024) >> 4) * 8 + ((u0 - 1024) & 7)) : u0;
        const bool sample = u >= 1024; int b, h, mp, qb = 0;
        if (!sample) { const int r = u >> 8, c = u & 255, xc = c & 7, j = c >> 3; const int bhm = (xc * 8 + (j >> 2)) * 2 + ((j >> 1) & 1), p2 = j & 1; qb = p2 == 0 ? (r == 0 ? 0 : r == 1 ? 7 : r == 2 ? 2 : 5) : (r == 0 ? 1 : r == 1 ? 6 : r == 2 ? 3 : 4); b = bhm >> 3; h = (bhm >> 1) & 3; mp = bhm & 1; }
        else { const int s = u - 1024; b = s >> 3; h = (s >> 1) & 3; mp = s & 1; }
        if (tid < 256) tab[tid] = P.in[8][t5_bucket(63 - tid) * 4 + h] * LOG2E;
        int t0, t1, w0, w1, nkeys, qpos, qpos_w0; long qrow; bool valid; size_t kbase; const bf16_t *kp, *vp;
        if (!sample) {
            kbase = (size_t)b * SEQ * 512 + h * 128; kp = (const bf16_t*)(ws + WS_KB); vp = (const bf16_t*)(ws + WS_VB);
            const int c0 = qb * 4, cw = c0 + (w >> 1);
            t0 = 0; t1 = c0 + 4; w0 = 0; w1 = cw + 1; nkeys = SEQ;
            qpos_w0 = qb * 256 + (w >> 1) * 64; qpos = qb * 256 + w * 32 + l31; qrow = (long)b * SEQ + qpos; valid = true;
        } else {
            kbase = (size_t)b * KB_ROWS * 512 + h * 128; kp = (const bf16_t*)(ws + WS_KBS); vp = (const bf16_t*)(ws + WS_VBS);
            t0 = 0; t1 = 17; w0 = 0; w1 = (w == 0) ? 17 : 0; nkeys = PAST + NEW;
            qpos_w0 = PAST; qpos = PAST + (l31 & 15); qrow = (long)TP + b * NEW + (l31 & 15); valid = (w == 0) && l31 < 16;
        }
        KVSrc S{kp + kbase + mp * 64, 512, nullptr, 0, vp + kbase, 512};
        bf16x8 qf[4]; load_q<4>(qf, QB + qrow * 512 + h * 128 + mp * 64, hi);
        f32x16 o[4];
#pragma unroll
        for (int db = 0; db < 4; ++db)
#pragma unroll
            for (int r = 0; r < 16; ++r) o[db][r] = 0.f;
        float m_run = NEGBIG, l_run = 0.f;
        flash_pass<64, 128, true, 64>(lds, S, t0, t1, w0, w1, nkeys, qf, qpos, qpos_w0, 0, o, m_run, l_run);
        l_run += __shfl_xor(l_run, 32);
        store_o<4>(mp == 0 ? O + qrow * 1024 + 512 + h * 128 : OT1 + qrow * 512 + h * 128, o, 1.0f / l_run, hi, valid);
    }
}
__device__ __forceinline__ void combine_b(const Params& P) {
    unsigned char* ws = P.ws; const int tid = opq_tid(), lane = tid & 63, gw = opq_bid() * 8 + (tid >> 6), nw = gridDim.x * 8;
    bf16_t* O = (bf16_t*)(ws + WS_O); const bf16_t* OT1 = (const bf16_t*)(ws + WS_OT1);
    const float lam = diff_lambda(P), lam_init = 0.2f;
    const int h = lane >> 4, e = (lane & 15) * 8;
    const f32x4 g0 = *(const f32x4*)(P.in[22] + e), g1 = *(const f32x4*)(P.in[22] + e + 4);
    for (int row = gw; row < MT; row += nw) {
        bf16_t* op = O + (size_t)row * 1024 + 512 + h * 128 + e;
        f32x4 a0, b0, a1, b1; unpack8(*(const u32x4*)op, a0, b0); unpack8(*(const u32x4*)(OT1 + (size_t)row * 512 + h * 128 + e), a1, b1);
        a0 -= a1 * lam; b0 -= b1 * lam;
        float ss = (a0[0] * a0[0] + a0[1] * a0[1]) + (a0[2] * a0[2] + a0[3] * a0[3]) + (b0[0] * b0[0] + b0[1] * b0[1]) + (b0[2] * b0[2] + b0[3] * b0[3]);
        ss += __shfl_xor(ss, 1); ss += __shfl_xor(ss, 2); ss += __shfl_xor(ss, 4); ss += __shfl_xor(ss, 8);
        const float rs = rsqrtf(ss * (1.0f / 128.0f) + EPS) * (1.0f - lam_init);
        *(u32x4*)op = pack8(a0 * rs * g0, b0 * rs * g1);
    }
}

__device__ __forceinline__ void attn_c(LAS unsigned char* lds, const Params& P) {
    unsigned char* ws = P.ws; const int tid = opq_tid(), lane = tid & 63, w = tid >> 6, l31 = lane & 31, hi = lane >> 5;
    bf16_t* O = (bf16_t*)(ws + WS_O); const bf16_t* QC = (const bf16_t*)(ws + WS_QC);
    const bf16_t* KVC = (const bf16_t*)(ws + WS_KVC); const bf16_t* KRB = (const bf16_t*)(ws + WS_KRB);
    for (int u = opq_bid(); u < 2048 + 256; u += gridDim.x) {
        const bool sample = u >= 2048; int b, h, qb = 0;
        if (!sample) { const int r = u >> 8, c = u & 255, xc = c & 7, j = c >> 3; const int bh = (r >> 1) * 64 + xc * 8 + (j >> 2), m4 = j & 3; qb = (r & 1) ? 7 - m4 : m4; b = bh >> 4; h = bh & 15; }
        else { const int s = u - 2048; b = s >> 4; h = s & 15; }
        int t0, t1, w0, w1, nkeys, qpos, qpos_w0; long qrow, krow0; bool valid;
        if (!sample) {
            krow0 = (long)b * SEQ; const int c0 = qb * 4, cw = c0 + (w >> 1);
            t0 = 0; t1 = c0 + 4; w0 = 0; w1 = cw + 1; nkeys = SEQ;
            qpos_w0 = qb * 256 + (w >> 1) * 64; qpos = qb * 256 + w * 32 + l31; qrow = (long)b * SEQ + qpos; valid = true;
        } else {
            krow0 = (long)TP + (long)b * (PAST + NEW);
            t0 = 0; t1 = 17; w0 = 0; w1 = (w == 0) ? 17 : 0; nkeys = PAST + NEW;
            qpos_w0 = PAST; qpos = PAST + (l31 & 15); qrow = (long)TP + b * NEW + (l31 & 15); valid = (w == 0) && l31 < 16;
        }
        const bf16_t* kvh = sample ? KVC + KVC_S_OFF + ((size_t)(b * 16 + h) * KC_ROWS) * 128 : KVC + ((size_t)(b * 16 + h) * SEQ) * 128;
        KVSrc S{kvh, 128, KRB + krow0 * 32, 32, kvh + 64, 128};
        bf16x8 qf[6]; load_q<6>(qf, QC + qrow * 1536 + h * 96, hi);
        f32x16 o[2];
#pragma unroll
        for (int db = 0; db < 2; ++db)
#pragma unroll
            for (int r = 0; r < 16; ++r) o[db][r] = 0.f;
        float m_run = NEGBIG, l_run = 0.f;
        flash_pass<96, 64, false, 128>(lds, S, t0, t1, w0, w1, nkeys, qf, qpos, qpos_w0, 0, o, m_run, l_run);
        l_run += __shfl_xor(l_run, 32);
        store_o<2>(O + qrow * 1024 + h * 64, o, 1.0f / l_run, hi, valid);
    }
}

#define XB_TMO      128
#define XB_XCNT(j)  (256  + 64 * (j))
#define XB_XSUB(j)  (1280 + 64 * (j))
#define XB_XGEN(j)  (2304 + 64 * (j))
#define XB_TOP      3328
#define XB_TOPGEN   3392
#define XCD_BAR_WORDS 3456
#define XB_SPIN_CAP (1u << 18)

__device__ __forceinline__ unsigned xb_ld(unsigned* p)              { return __hip_atomic_load(p, __ATOMIC_RELAXED, __HIP_MEMORY_SCOPE_AGENT); }
__device__ __forceinline__ unsigned xb_add(unsigned* p, unsigned v) { return __hip_atomic_fetch_add(p, v, __ATOMIC_RELAXED, __HIP_MEMORY_SCOPE_AGENT); }
__device__ __forceinline__ unsigned xb_xcc_id() { return (unsigned)__builtin_amdgcn_s_getreg((3 << 11) | 20) & 0xFu; }
#define XB_SPIN(cond, bar) do { unsigned _sp = 0; while (cond) { __builtin_amdgcn_s_sleep(1); \
    if ((++_sp & 255u) == 0u) { if (xb_ld(&(bar)[XB_TMO])) break; if (_sp > XB_SPIN_CAP) { atomicAdd(&(bar)[XB_TMO], 1u); break; } } } } while (0)

struct XcdBarrier {
    unsigned* bar; unsigned x;
    volatile LAS unsigned* st;
};

__device__ __forceinline__ XcdBarrier xcd_barrier_post(unsigned* bar, volatile LAS unsigned* st) {
    XcdBarrier b; b.bar = bar; b.x = xb_xcc_id(); b.st = st;
    if (threadIdx.x == 0) (void)xb_add(&bar[XB_XCNT(b.x)], 1u);
    return b;
}
__device__ __forceinline__ void xcd_barrier_complete(unsigned* bar, unsigned x, unsigned& nloc, unsigned& nx) {
    const unsigned G = gridDim.x * gridDim.y * gridDim.z;
    unsigned sum, cnt, mine, sp = 0u;
    for (;;) {
        sum = 0u; cnt = 0u; mine = 0u;
#pragma unroll
        for (unsigned j = 0; j < 16; ++j) { const unsigned c = xb_ld(&bar[XB_XCNT(j)]); sum += c; cnt += (c > 0u) ? 1u : 0u; mine = (j == x) ? c : mine; }
        if (sum == G) break;
        __builtin_amdgcn_s_sleep(1);
        if ((++sp & 255u) == 0u) { if (xb_ld(&bar[XB_TMO])) break; if (sp > XB_SPIN_CAP) { atomicAdd(&bar[XB_TMO], 1u); break; } }
    }
    nloc = mine > 0u ? mine : 1u; nx = cnt > 0u ? cnt : 1u;
}

__device__ __forceinline__ void xcd_barrier(const XcdBarrier& b) {
    asm volatile("s_waitcnt vmcnt(0)" ::: "memory");
    __syncthreads();
    if (threadIdx.x == 0) {
        unsigned* bar = b.bar;
        __builtin_amdgcn_s_waitcnt(0);
        unsigned nloc = b.st[0], nx = b.st[1];
        if (nloc == 0u) { xcd_barrier_complete(bar, b.x, nloc, nx); b.st[0] = nloc; b.st[1] = nx; }
        const unsigned old = xb_add(&bar[XB_XSUB(b.x)], 1u);
        const unsigned gen = old / nloc;
        if (old + 1u == (gen + 1u) * nloc) {
            __builtin_amdgcn_fence(__ATOMIC_RELEASE, "agent");
            asm volatile("s_waitcnt vmcnt(0)" ::: "memory");
            const unsigned og = xb_add(&bar[XB_TOP], 1u);
            const unsigned tg = og / nx;
            if (og + 1u == (tg + 1u) * nx) xb_add(&bar[XB_TOPGEN], 1u);
            else XB_SPIN(xb_ld(&bar[XB_TOPGEN]) == tg, bar);
            __builtin_amdgcn_fence(__ATOMIC_ACQUIRE, "agent");
            xb_add(&bar[XB_XGEN(b.x)], 1u);
            asm volatile("s_waitcnt vmcnt(0)" ::: "memory");
        } else {
            XB_SPIN(xb_ld(&bar[XB_XGEN(b.x)]) == gen, bar);
            __builtin_amdgcn_fence(__ATOMIC_ACQUIRE, "agent");
            asm volatile("s_waitcnt vmcnt(0)" ::: "memory");
        }
    }
    __syncthreads();
}


constexpr int N_PHASES = 18;
__global__ void __launch_bounds__(512, 2) fwd_megakernel(Params P) {
    extern __shared__ __attribute__((aligned(16))) unsigned char lds_raw[];
    LAS unsigned char* lds = (LAS unsigned char*)lds_raw;
    cg::grid_group grid = cg::this_grid();
    unsigned char* ws = P.ws; float* x = P.out;
    bf16_t* xb = (bf16_t*)(ws + WS_XB); float* ssp = (float*)(ws + WS_SSP); float* ssps = (float*)(ws + WS_SSPS); bf16_t* act = (bf16_t*)(ws + WS_ACT); bf16_t* O = (bf16_t*)(ws + WS_O);
    const int lo = P.ph_lo, hi = P.ph_hi;
    volatile LAS unsigned* bst = (volatile LAS unsigned*)(lds + 131072);
    if (threadIdx.x < 2) bst[threadIdx.x] = 0u;
    __syncthreads();
    XcdBarrier bar = xcd_barrier_post((unsigned*)(ws + WS_CTL), bst);
#define PH(k) if (lo <= (k) && (k) < hi)
#define SEAM(k) if (lo <= (k) && (k) + 1 < hi) { if ((k) == 0) grid.sync(); else xcd_barrier(bar); }
    PH(0) { prologue(lds, P);
#ifdef PROBE_PRO2
        prologue(lds, P);
#endif
    } SEAM(0)
#define WGU(i) ((const bf16_t*)(ws + W_GU + (size_t)(i) * W_GU_SZ))
#define WDN(i) ((const bf16_t*)(ws + W_DN + (size_t)(i) * W_DN_SZ))
    PH(1) { skinny_gemm<4, 4>(xb + (size_t)TP * D, WGU(0), D, FF / 32, SkSwiglu4{act, ssps}); run_gemm(lds, xb, WGU(0), TP, 2 * FF, D, EpiSwiglu{act, ssp});
#ifdef PROBE_UP2
        skinny_gemm<4, 4>(xb + (size_t)TP * D, WGU(0), D, FF / 32, SkSwiglu4{act, ssps}); run_gemm(lds, xb, WGU(0), TP, 2 * FF, D, EpiSwiglu{act, ssp});
#endif
    } SEAM(1)
    PH(2) {
#ifdef PROBE_DN2
        skinny_gemm<1, 11>(act + (size_t)TP * FF, WDN(0), FF, D / 16, SkResid{x, xb, ssps, 0.25f}); run_gemm(lds, act, WDN(0), TP, D, FF, EpiResid{x, xb, ssp, 0.25f});
        skinny_gemm<1, 11>(act + (size_t)TP * FF, WDN(0), FF, D / 16, SkResid{x, xb, ssps, 0.25f}); run_gemm(lds, act, WDN(0), TP, D, FF, EpiResid{x, xb, ssp, 0.25f});
#else
        skinny_gemm<1, 11, SkResid, 2>(act + (size_t)TP * FF, WDN(0), FF, D / 16, SkResid{x, xb, ssps, 0.5f}, 0, lds); run_gemm(lds, act, WDN(0), TP, D, FF, EpiResid{x, xb, ssp, 0.5f});
#endif
 } SEAM(2)
    PH(3) { skinny_gemm<1, 8>(xb + (size_t)TP * D, (const bf16_t*)(ws + W_IN0), D, 192, SkIn0{ssps, ws, P.out}); run_gemm(lds, xb, (const bf16_t*)(ws + W_IN0), TP, 3072, D, EpiIn0{ssp, ws, P.out}); } SEAM(3)
    PH(4) {
#ifndef DIS_A
        attn_a(lds, P);
#endif
#ifndef DIS_B
        attn_b(lds, P);
#endif
#ifdef PROBE_ATT2
        attn_a(lds, P); attn_b(lds, P);
#endif
        if (hi > 5) { xcd_barrier(bar); combine_b(P); }
    } SEAM(4)
    PH(5) { skinny_gemm<1, 4, SkResid, 2>(O + (size_t)TP * D, (const bf16_t*)(ws + W_OUT0), D, D / 16, SkResid{x, xb, ssps, 1.0f}, 0, lds); run_gemm(lds, O, (const bf16_t*)(ws + W_OUT0), TP, D, D, EpiResid{x, xb, ssp, 1.0f}); } SEAM(5)
    PH(6) { skinny_gemm<4, 4>(xb + (size_t)TP * D, WGU(1), D, FF / 32, SkSwiglu4{act, ssps}); run_gemm(lds, xb, WGU(1), TP, 2 * FF, D, EpiSwiglu{act, ssp});
#ifdef PROBE_UP2
        skinny_gemm<4, 4>(xb + (size_t)TP * D, WGU(1), D, FF / 32, SkSwiglu4{act, ssps}); run_gemm(lds, xb, WGU(1), TP, 2 * FF, D, EpiSwiglu{act, ssp});
#endif
    } SEAM(6)
    PH(7) {
#ifdef PROBE_DN2
        skinny_gemm<1, 11>(act + (size_t)TP * FF, WDN(1), FF, D / 16, SkResid{x, xb, ssps, 0.25f}); run_gemm(lds, act, WDN(1), TP, D, FF, EpiResid{x, xb, ssp, 0.25f});
        skinny_gemm<1, 11>(act + (size_t)TP * FF, WDN(1), FF, D / 16, SkResid{x, xb, ssps, 0.25f}); run_gemm(lds, act, WDN(1), TP, D, FF, EpiResid{x, xb, ssp, 0.25f});
#else
        skinny_gemm<1, 11, SkResid, 2>(act + (size_t)TP * FF, WDN(1), FF, D / 16, SkResid{x, xb, ssps, 0.5f}, 0, lds); run_gemm(lds, act, WDN(1), TP, D, FF, EpiResid{x, xb, ssp, 0.5f});
#endif
 } SEAM(7)
    PH(8) { skinny_gemm<4, 4>(xb + (size_t)TP * D, WGU(2), D, FF / 32, SkSwiglu4{act, ssps}); run_gemm(lds, xb, WGU(2), TP, 2 * FF, D, EpiSwiglu{act, ssp});
#ifdef PROBE_UP2
        skinny_gemm<4, 4>(xb + (size_t)TP * D, WGU(2), D, FF / 32, SkSwiglu4{act, ssps}); run_gemm(lds, xb, WGU(2), TP, 2 * FF, D, EpiSwiglu{act, ssp});
#endif
    } SEAM(8)
    PH(9) {
#ifdef PROBE_DN2
        skinny_gemm<1, 11>(act + (size_t)TP * FF, WDN(2), FF, D / 16, SkResid{x, xb, ssps, 0.25f}); run_gemm(lds, act, WDN(2), TP, D, FF, EpiResid{x, xb, ssp, 0.25f});
        skinny_gemm<1, 11>(act + (size_t)TP * FF, WDN(2), FF, D / 16, SkResid{x, xb, ssps, 0.25f}); run_gemm(lds, act, WDN(2), TP, D, FF, EpiResid{x, xb, ssp, 0.25f});
#else
        skinny_gemm<1, 11, SkResid, 2>(act + (size_t)TP * FF, WDN(2), FF, D / 16, SkResid{x, xb, ssps, 0.5f}, 0, lds); run_gemm(lds, act, WDN(2), TP, D, FF, EpiResid{x, xb, ssp, 0.5f});
#endif
 } SEAM(9)
    PH(10) {
        const int G = (int)gridDim.x, half = G / 2;
        if ((int)blockIdx.x >= half) prologue_l1(P, (int)blockIdx.x - half, G - half);
        skinny_gemm<1, 8>(xb + (size_t)TP * D, (const bf16_t*)(ws + W_IN1), D, 42, SkIn1{ssps, ws, P.out}, half); run_gemm(lds, xb, (const bf16_t*)(ws + W_IN1), TP, 768, D, EpiIn1{ssp, ws, P.out}); } SEAM(10)
    PH(11) { thin_l1(P); skinny_gemm<1, 6>((const bf16_t*)(ws + WS_CQ) + (size_t)TP * 384, (const bf16_t*)(ws + W_QUP), 384, 96, SkQup{ws}); run_gemm(lds, (const bf16_t*)(ws + WS_CQ), (const bf16_t*)(ws + W_QUP), TP, 1536, 384, EpiQup{ws}); } SEAM(11)
    PH(12) { skinny_gemm<1, 4>((const bf16_t*)(ws + WS_CKVN) + (size_t)(MKV - 256) * 256, (const bf16_t*)(ws + W_KVUP), 256, 128, SkKvHead{(bf16_t*)(ws + WS_KVC)});
        run_gemm(lds, (const bf16_t*)(ws + WS_CKVN), (const bf16_t*)(ws + W_KVUP), MKV - 256, 2048, 256, EpiKvHead{(bf16_t*)(ws + WS_KVC)}); } SEAM(12)
    PH(13) {
#ifndef DIS_C
        attn_c(lds, P);
#endif
#ifdef PROBE_ATTC2
        attn_c(lds, P);
#endif
    } SEAM(13)
    PH(14) { skinny_gemm<1, 4, SkResid, 2>(O + (size_t)TP * D, (const bf16_t*)(ws + W_OUT1), D, D / 16, SkResid{x, xb, ssps, 1.0f}, 0, lds); run_gemm(lds, O, (const bf16_t*)(ws + W_OUT1), TP, D, D, EpiResid{x, xb, ssp, 1.0f}); } SEAM(14)
    PH(15) { skinny_gemm<4, 4>(xb + (size_t)TP * D, WGU(3), D, FF / 32, SkSwiglu4{act, ssps}); run_gemm(lds, xb, WGU(3), TP, 2 * FF, D, EpiSwiglu{act, ssp});
#ifdef PROBE_UP2
        skinny_gemm<4, 4>(xb + (size_t)TP * D, WGU(3), D, FF / 32, SkSwiglu4{act, ssps}); run_gemm(lds, xb, WGU(3), TP, 2 * FF, D, EpiSwiglu{act, ssp});
#endif
    } SEAM(15)
    PH(16) {
#ifdef PROBE_DN2
        skinny_gemm<1, 11>(act + (size_t)TP * FF, WDN(3), FF, D / 16, SkResid{x, xb, ssps, 0.25f}); run_gemm(lds, act, WDN(3), TP, D, FF, EpiResid{x, xb, ssp, 0.25f});
        skinny_gemm<1, 11>(act + (size_t)TP * FF, WDN(3), FF, D / 16, SkResid{x, xb, ssps, 0.25f}); run_gemm(lds, act, WDN(3), TP, D, FF, EpiResid{x, xb, ssp, 0.25f});
#else
        skinny_gemm<1, 11, SkResid, 2>(act + (size_t)TP * FF, WDN(3), FF, D / 16, SkResid{x, xb, ssps, 0.5f}, 0, lds); run_gemm(lds, act, WDN(3), TP, D, FF, EpiResid{x, xb, ssp, 0.5f});
#endif
 } SEAM(16)
    const int ph = 17;
    PH(ph) { final_norm(P); }
#undef PH
#undef SEAM
}

#ifndef MK_SPLIT
#define MK_SPLIT 0
#endif
extern "C" void kernel_launch(void* const* d_in, const int* in_sizes, int n_in, void* d_out, int out_size, void* d_ws, size_t ws_size, hipStream_t stream) {
    static int grid_blocks = 0;
    if (grid_blocks == 0) {
        if (n_in != 31 || (size_t)out_size != O_END || ws_size < WS_CTL + CTL_BYTES) { fprintf(stderr, "kernel_launch: unexpected sizes n_in %d out %d ws %zu (need %zu)\n", n_in, out_size, ws_size, (size_t)WS_END); grid_blocks = -1; return; }
        int dev = 0, cus = 0, per_cu = 0;
        hipGetDevice(&dev); hipDeviceGetAttribute(&cus, hipDeviceAttributeMultiprocessorCount, dev);
        if (hipFuncSetAttribute((const void*)fwd_megakernel, hipFuncAttributeMaxDynamicSharedMemorySize, LDS_BYTES) != hipSuccess) { fprintf(stderr, "kernel_launch: hipFuncSetAttribute failed\n"); grid_blocks = -1; return; }
        if (hipOccupancyMaxActiveBlocksPerMultiprocessor(&per_cu, (const void*)fwd_megakernel, 512, LDS_BYTES) != hipSuccess || per_cu < 1) { fprintf(stderr, "kernel_launch: occupancy query says %d\n", per_cu); per_cu = 1; }
        (void)hipGetLastError();
        grid_blocks = cus * per_cu;
        fprintf(stderr, "kernel_launch: grid %d (cus %d x %d)\n", grid_blocks, cus, per_cu);
    }
    if (grid_blocks < 0) return;
    if (hipMemsetAsync((char*)d_ws + WS_CTL, 0, CTL_BYTES, stream) != hipSuccess) { fprintf(stderr, "kernel_launch: memset failed\n"); return; }
    Params p{};
    for (int i = 0; i < 31; ++i) p.in[i] = (const float*)d_in[i];
    p.out = (float*)d_out; p.ws = (unsigned char*)d_ws;
#if MK_SPLIT
    for (int k = 0; k < N_PHASES; ++k) { p.ph_lo = k; p.ph_hi = k + 1; hipLaunchKernelGGL(fwd_megakernel, dim3(grid_blocks), dim3(512), LDS_BYTES, stream, p); }
#else
    p.ph_lo = 0; p.ph_hi = N_PHASES;
    void* args[] = {&p};
    hipError_t e = hipLaunchCooperativeKernel((const void*)fwd_megakernel, dim3(grid_blocks), dim3(512), args, LDS_BYTES, stream);
    if (e != hipSuccess) fprintf(stderr, "kernel_launch: cooperative launch failed: %s (grid %d)\n", hipGetErrorString(e), grid_blocks);
#endif
}
```

```cpp
#include <hip/hip_runtime.h>
#include <cstdio>
#include <cstdint>
namespace pg8 {
#define PG8_LAS __attribute__((address_space(3)))
typedef unsigned short bf16_t;
typedef short bf16x8 __attribute__((ext_vector_type(8)));
typedef float f32x4 __attribute__((ext_vector_type(4)));
typedef unsigned u32x4 __attribute__((ext_vector_type(4)));
constexpr int BM = 256, BK = 64, HALF = 128, HTB = HALF * BK * 2  , STAGE_BYTES = 8 * HTB, NXCD = 8, WGM = 8;

__host__ __device__ __forceinline__ int lds_byte(int r, int c) { const int st = (r >> 4) * 2 + (c >> 5), rr = r & 15, cc = c & 31, ob = rr * 64 + cc * 2; return st * 1024 + (ob ^ (((ob >> 9) & 1) << 5)); }
__host__ __device__ __forceinline__ void stage_rc(int b, int& R, int& C) { const int st = b / 1024, sb = b % 1024, swz = sb ^ (((sb >> 9) & 1) << 5); R = (st >> 1) * 16 + swz / 64; C = (st & 1) * 32 + (swz % 64) / 2; }
__host__ __device__ __forceinline__ int perm32(int rho) { const int n = rho >> 4, i = rho & 15; return 8 * (i >> 2) + 4 * n + (i & 3); }

struct Unit { int pm, pn; };
struct Gemm { const bf16_t* A; const bf16_t* Bt; int M, N, K; };

struct StaticOrder {
    int nM, nN, nwg, G, c;
    __host__ __device__ void init(int M, int N, int G_, int c_) { nM = M / BM; nN = N / BM; nwg = nM * nN; G = G_; c = c_; }
    __host__ __device__ bool next(int i, Unit& u) const {
        const long L = (long)i * G + c; if (L >= nwg) return false;
        int wgid = (int)L; { const int q = nwg / NXCD, r = nwg % NXCD, xcd = wgid % NXCD, off = wgid / NXCD; wgid = (xcd < r ? xcd * (q + 1) : r * (q + 1) + (xcd - r) * q) + off; }
        const int nig = WGM * nN, gid = wgid / nig, fm = gid * WGM, gsz = (nM - fm) < WGM ? (nM - fm) : WGM;
        u.pm = fm + ((wgid % nig) % gsz); u.pn = (wgid % nig) / gsz; return true;
    }
    __device__ __forceinline__ void a_ready(const Unit&) const {}
    __device__ __forceinline__ void done(const Unit&) const {}
};
__device__ __forceinline__ unsigned cvt_pk_bf16(float lo, float hi) { unsigned r; asm volatile("v_cvt_pk_bf16_f32 %0, %1, %2" : "=v"(r) : "v"(lo), "v"(hi)); return r; }
template <class Epi, class Sched, bool ALIGN_EPI = false, bool SP2 = false>
__device__ __forceinline__ void gemm_phase(PG8_LAS unsigned char* lds, const Gemm g, const Sched& S, const Epi& E) {
    const int tid = threadIdx.x, wid = __builtin_amdgcn_readfirstlane(tid >> 6), lane = tid & 63, wr = wid >> 2, wc = wid & 3, fr = lane & 15, fq = lane >> 4;
    const int K = g.K, nt = K / BK;
    unsigned voffA[2], voffB[2];
#pragma unroll
    for (int i = 0; i < 2; ++i) { int R, C; stage_rc(tid * 16 + i * 8192, R, C); const int Rb = Epi::PERM ? ((R & ~31) + perm32(R & 31)) : R;
        voffA[i] = (unsigned)(R * K + C) * 2u; voffB[i] = (unsigned)(Rb * K + C) * 2u; }
    const size_t kstep = (size_t)(BK * 2);
    const size_t hstep = (size_t)HALF * K * 2;
    const size_t tstep = 2 * hstep;
    const unsigned ldsw = (unsigned)wid * 1024u;
    const int aoff = lds_byte(wr * 64 + fr, fq * 8), boff = lds_byte(wc * 32 + fr, fq * 8);
#define PG8_SA(b, h) (((b) * 2 + (h)) * HTB)
#define PG8_SB(b, h) ((4 + (b) * 2 + (h)) * HTB)
#define PG8_STAGE(bufoff, gbase, voff) do { _Pragma("unroll") for (int _i = 0; _i < 2; ++_i) \
        __builtin_amdgcn_global_load_lds((const unsigned*)((const char*)(gbase) + (voff)[_i]), (PG8_LAS unsigned*)(lds + (bufoff) + ldsw + _i * 8192), 16, 0, 0); } while (0)
#define PG8_LDA(dst, b, h) do { _Pragma("unroll") for (int m = 0; m < 4; ++m) _Pragma("unroll") for (int k = 0; k < 2; ++k) dst[m][k] = *(const PG8_LAS bf16x8*)(lds + PG8_SA(b, h) + aoff + m * 2048 + k * 1024); } while (0)
#define PG8_LDB(dst, b, h) do { _Pragma("unroll") for (int n = 0; n < 2; ++n) _Pragma("unroll") for (int k = 0; k < 2; ++k) dst[n][k] = *(const PG8_LAS bf16x8*)(lds + PG8_SB(b, h) + boff + n * 2048 + k * 1024); } while (0)
#define PG8_MMA(ai, bj, At, Bt) do { __builtin_amdgcn_s_setprio(1); _Pragma("unroll") for (int m = 0; m < 4; ++m) _Pragma("unroll") for (int n = 0; n < 2; ++n) _Pragma("unroll") for (int k = 0; k < 2; ++k) \
        acc[ai][bj][m][n] = __builtin_amdgcn_mfma_f32_16x16x32_bf16(Bt[n][k], At[m][k], acc[ai][bj][m][n], 0, 0, 0); __builtin_amdgcn_s_setprio(0); } while (0)
#define PG8_WAIT_V(n) asm volatile("s_waitcnt vmcnt(" #n ")" ::: "memory")
#define PG8_WAIT_L(n) asm volatile("s_waitcnt lgkmcnt(" #n ")" ::: "memory")
#define PG8_BAR __builtin_amdgcn_s_barrier()
#define PG8_SCHED __builtin_amdgcn_sched_barrier(0)
    Unit cur, nxt; int ui = 0;
    if (!S.next(0, cur)) return;
    f32x4 acc[2][2][4][2];
#pragma unroll
    for (int a = 0; a < 2; ++a)
#pragma unroll
        for (int b = 0; b < 2; ++b)
#pragma unroll
            for (int m = 0; m < 4; ++m)
#pragma unroll
                for (int n = 0; n < 2; ++n) acc[a][b][m][n] = (f32x4){0.f, 0.f, 0.f, 0.f};
    bf16x8 At[4][2], B0[2][2], B1[2][2];
    const char* cA = (const char*)g.A + (size_t)cur.pm * tstep; const char* cB = (const char*)g.Bt + (size_t)cur.pn * tstep;
    S.a_ready(cur);
    if constexpr (SP2) {
        PG8_STAGE(PG8_SB(0, 0), cB, voffB); PG8_STAGE(PG8_SB(0, 1), cB + hstep, voffB); PG8_STAGE(PG8_SA(0, 0), cA, voffA); PG8_STAGE(PG8_SA(0, 1), cA + hstep, voffA);
        if (wr == 1) PG8_BAR;
        PG8_WAIT_V(2); PG8_BAR;
        PG8_STAGE(PG8_SB(1, 0), cB + kstep, voffB); PG8_STAGE(PG8_SA(1, 0), cA + kstep, voffA); PG8_STAGE(PG8_SB(1, 1), cB + hstep + kstep, voffB);
        PG8_WAIT_V(6); PG8_BAR;
    } else {
        PG8_STAGE(PG8_SB(0, 0), cB, voffB); PG8_STAGE(PG8_SA(0, 0), cA, voffA); PG8_STAGE(PG8_SB(0, 1), cB + hstep, voffB); PG8_STAGE(PG8_SA(0, 1), cA + hstep, voffA);
        if (wr == 1) PG8_BAR;
        PG8_WAIT_V(4); PG8_BAR;
        PG8_STAGE(PG8_SB(1, 0), cB + kstep, voffB); PG8_STAGE(PG8_SA(1, 0), cA + kstep, voffA); PG8_STAGE(PG8_SB(1, 1), cB + hstep + kstep, voffB);
        PG8_WAIT_V(6); PG8_BAR;
    }
    for (;;) {
        const bool has_next = S.next(ui + 1, nxt);
        const char* nA = has_next ? (const char*)g.A + (size_t)nxt.pm * tstep : cA; const char* nB = has_next ? (const char*)g.Bt + (size_t)nxt.pn * tstep : cB;
        for (int t = 0; t < nt; t += 2) {
            const bool last = (t == nt - 2);
            const char* a1 = cA + (size_t)(t + 1) * kstep;
            const char* a2 = last ? nA : cA + (size_t)(t + 2) * kstep; const char* b2 = last ? nB : cB + (size_t)(t + 2) * kstep;
            const char* a3 = a2 + kstep; const char* b3 = b2 + kstep;
            if (last && has_next) S.a_ready(nxt);
            if constexpr (SP2) {
            PG8_LDB(B0, 0, 0); PG8_LDB(B1, 0, 1); PG8_SCHED; PG8_LDA(At, 0, 0); PG8_STAGE(PG8_SA(1, 1), a1 + hstep, voffA);
            PG8_WAIT_V(8); PG8_WAIT_L(0); PG8_BAR; PG8_MMA(0, 0, At, B0); PG8_MMA(0, 1, At, B1); PG8_BAR; PG8_SCHED;
            PG8_LDA(At, 0, 1); PG8_STAGE(PG8_SB(0, 0), b2, voffB); PG8_STAGE(PG8_SB(0, 1), b2 + hstep, voffB); PG8_STAGE(PG8_SA(0, 0), a2, voffA);
            PG8_WAIT_V(8); PG8_WAIT_L(0); PG8_BAR; PG8_MMA(1, 0, At, B0); PG8_MMA(1, 1, At, B1); PG8_BAR; PG8_SCHED;
            PG8_LDB(B0, 1, 0); PG8_LDB(B1, 1, 1); PG8_SCHED; PG8_LDA(At, 1, 0); PG8_STAGE(PG8_SA(0, 1), a2 + hstep, voffA);
            PG8_WAIT_V(8); PG8_WAIT_L(0); PG8_BAR; PG8_MMA(0, 0, At, B0); PG8_MMA(0, 1, At, B1); PG8_BAR; PG8_SCHED;
            PG8_LDA(At, 1, 1); PG8_STAGE(PG8_SB(1, 0), b3, voffB); PG8_STAGE(PG8_SB(1, 1), b3 + hstep, voffB); PG8_STAGE(PG8_SA(1, 0), a3, voffA);
            PG8_WAIT_V(8); PG8_WAIT_L(0); PG8_BAR; PG8_MMA(1, 0, At, B0); PG8_MMA(1, 1, At, B1); PG8_BAR; PG8_SCHED;
            } else {
            PG8_LDB(B0, 0, 0); PG8_SCHED; PG8_LDA(At, 0, 0); PG8_STAGE(PG8_SA(1, 1), a1 + hstep, voffA);
            PG8_WAIT_L(8); PG8_BAR; PG8_WAIT_L(0); PG8_MMA(0, 0, At, B0); PG8_BAR; PG8_SCHED;
            PG8_LDB(B1, 0, 1); PG8_STAGE(PG8_SB(0, 0), b2, voffB);
            PG8_BAR; PG8_WAIT_L(0); PG8_MMA(0, 1, At, B1); PG8_BAR;
            PG8_LDA(At, 0, 1); PG8_STAGE(PG8_SA(0, 0), a2, voffA);
            PG8_BAR; PG8_WAIT_L(0); PG8_MMA(1, 0, At, B0); PG8_BAR; PG8_SCHED;
            PG8_STAGE(PG8_SB(0, 1), b2 + hstep, voffB);
            PG8_WAIT_V(6); PG8_BAR; PG8_MMA(1, 1, At, B1); PG8_BAR;
            PG8_LDB(B0, 1, 0); PG8_SCHED; PG8_LDA(At, 1, 0); PG8_STAGE(PG8_SA(0, 1), a2 + hstep, voffA);
            PG8_WAIT_L(8); PG8_BAR; PG8_WAIT_L(0); PG8_MMA(0, 0, At, B0); PG8_BAR; PG8_SCHED;
            PG8_LDB(B1, 1, 1); PG8_STAGE(PG8_SB(1, 0), b3, voffB);
            PG8_BAR; PG8_WAIT_L(0); PG8_MMA(0, 1, At, B1); PG8_BAR;
            PG8_LDA(At, 1, 1); PG8_STAGE(PG8_SA(1, 0), a3, voffA);
            PG8_BAR; PG8_WAIT_L(0); PG8_MMA(1, 0, At, B0); PG8_BAR; PG8_SCHED;
            PG8_STAGE(PG8_SB(1, 1), b3 + hstep, voffB);
            PG8_WAIT_V(6); PG8_BAR; PG8_MMA(1, 1, At, B1); PG8_BAR;
            }
        }
        if constexpr (ALIGN_EPI) { if (wr == 0) PG8_BAR; }
        if constexpr (!Epi::AFTER_DRAIN) { E(acc, cur, wr, wc, fr, fq); S.done(cur); }
        if (!has_next) break;
#pragma unroll
        for (int a = 0; a < 2; ++a)
#pragma unroll
            for (int b = 0; b < 2; ++b)
#pragma unroll
                for (int m = 0; m < 4; ++m)
#pragma unroll
                    for (int n = 0; n < 2; ++n) acc[a][b][m][n] = (f32x4){0.f, 0.f, 0.f, 0.f};
        cur = nxt; cA = nA; cB = nB; ++ui;
        if constexpr (ALIGN_EPI) { if (wr == 1) PG8_BAR; }
    }
    PG8_WAIT_V(0);
    if constexpr (!ALIGN_EPI) { if (wr == 0) PG8_BAR; }
    PG8_BAR;
    if constexpr (Epi::AFTER_DRAIN) { E.fused(acc, cur, wr, wc, fr, fq, lds, wid, lane); S.done(cur); }
#undef PG8_SA
#undef PG8_SB
#undef PG8_STAGE
#undef PG8_LDA
#undef PG8_LDB
#undef PG8_MMA
#undef PG8_WAIT_V
#undef PG8_WAIT_L
#undef PG8_BAR
#undef PG8_SCHED
}
}

#include <hip/hip_cooperative_groups.h>
namespace cg = cooperative_groups;
#define LAS __attribute__((address_space(3)))
typedef unsigned short bf16_t;
typedef short bf16x8 __attribute__((ext_vector_type(8)));
typedef short s16x4 __attribute__((ext_vector_type(4)));
typedef float f32x4 __attribute__((ext_vector_type(4)));
typedef float f32x16 __attribute__((ext_vector_type(16)));
typedef unsigned u32x4 __attribute__((ext_vector_type(4)));
typedef unsigned u32x2 __attribute__((ext_vector_type(2)));
using pg8::cvt_pk_bf16;

constexpr int TP = 32768, TS = 256, MT = TP + TS;
constexpr int D = 1024, FF = 2816, SEQ = 2048, NB = 16, NEW = 16, PAST = 1024;
constexpr int SROWS_C = NB * (PAST + NEW);
constexpr int MKV = TP + SROWS_C;
constexpr int KA_ROWS = 576, KB_ROWS = 1088;
constexpr float EPS = 1e-6f, LOG2E = 1.4426950408889634f;
constexpr float QS_AB = 0.125f * LOG2E;
constexpr float QS_C = 0.10206207261596575f * LOG2E;
constexpr float NEGBIG = -1e30f;

constexpr size_t O_Y = 0, O_PAK = (size_t)MT * D, O_PAV = O_PAK + 4194304, O_PBK = O_PAV + 4194304, O_PBV = O_PBK + 16777216,
                 O_PCKV = O_PBV + 16777216, O_PCKR = O_PCKV + 8388608, O_SAK = O_PCKR + 1048576, O_SAV = O_SAK + 131072,
                 O_SBK = O_SAV + 131072, O_SBV = O_SBK + 131072, O_SCKV = O_SBV + 131072, O_SCKR = O_SCKV + 65536, O_END = O_SCKR + 8192;
static_assert(O_END == 85794816, "d_out map");

constexpr size_t al256(size_t x) { return (x + 255) & ~(size_t)255; }
constexpr size_t W_GU = 0;
constexpr size_t W_GU_SZ = (size_t)5632 * 1024 * 2;
constexpr size_t W_DN = W_GU + 4 * W_GU_SZ;
constexpr size_t W_DN_SZ = (size_t)1024 * 2816 * 2;
constexpr size_t W_IN0 = W_DN + 4 * W_DN_SZ;
constexpr size_t W_OUT0 = W_IN0 + (size_t)3072 * 1024 * 2;
constexpr size_t W_IN1 = W_OUT0 + (size_t)1024 * 1024 * 2;
constexpr size_t W_QUP = W_IN1 + (size_t)768 * 1024 * 2;
constexpr size_t W_KVUP = W_QUP + (size_t)1536 * 384 * 2;
constexpr size_t W_OUT1 = W_KVUP + (size_t)2048 * 256 * 2;
constexpr size_t WS_XB = W_OUT1 + (size_t)1024 * 1024 * 2;
constexpr size_t WS_SSP = WS_XB + (size_t)MT * D * 2;
constexpr size_t WS_SSC = WS_SSP + (size_t)MT * 16 * 4;
constexpr size_t WS_ROPE = WS_SSC + (size_t)MT * 24 * 4;
constexpr size_t WS_SSPS = WS_ROPE + (size_t)2048 * 16 * 8;
constexpr size_t WS_SSCS = WS_SSPS + (size_t)TS * 64 * 4;
constexpr size_t WS_M = al256(WS_SSCS + (size_t)TS * 40 * 4);
constexpr size_t WS_ACT = WS_M;
constexpr size_t QKV_SZ = (size_t)MT * 512 * 2;
constexpr size_t WS_O = WS_M;
constexpr size_t WS_QA = WS_O + (size_t)MT * D * 2, WS_KA = WS_QA + QKV_SZ, WS_VA = WS_KA + QKV_SZ, WS_QB = WS_VA + QKV_SZ, WS_KB = WS_QB + QKV_SZ, WS_VB = WS_KB + QKV_SZ;
constexpr size_t WS_KAS = WS_VB + QKV_SZ, KAS_SZ = (size_t)NB * KA_ROWS * 512 * 2, WS_VAS = WS_KAS + KAS_SZ;
constexpr size_t WS_KBS = WS_VAS + KAS_SZ, KBS_SZ = (size_t)NB * KB_ROWS * 512 * 2, WS_VBS = WS_KBS + KBS_SZ;
constexpr size_t WS_OT1 = WS_VBS + KBS_SZ;
constexpr size_t WS_L0_END = WS_OT1 + QKV_SZ;
constexpr size_t WS_CQ = WS_M;
constexpr size_t WS_CKVN = WS_CQ + (size_t)MT * 384 * 2;
static_assert(WS_CKVN + (size_t)(MKV + 128) * 256 * 2 <= WS_M + (size_t)MT * D * 2, "cq|ckvn inside the O overlay");
constexpr size_t WS_KRB = WS_O + (size_t)MT * D * 2;
constexpr size_t WS_QC = al256(WS_KRB + (size_t)(MKV + 128) * 32 * 2);
constexpr size_t WS_KVC = WS_QC + (size_t)MT * 1536 * 2;
constexpr size_t WS_L1_END = WS_KVC + ((size_t)NB * 16 * SEQ * 128 + (size_t)NB * 16 * 1040 * 128 + 128 * 128) * 2;
constexpr size_t WS_END = WS_L1_END > WS_L0_END ? WS_L1_END : WS_L0_END;
constexpr int XCD_BAR_WORDS_C = 3456;
constexpr size_t WS_CTL = al256(WS_END), CTL_BYTES = 16384;
static_assert(WS_CTL + CTL_BYTES <= (size_t)512 * 1024 * 1024, "d_ws map exceeds 512 MiB");
static_assert(XCD_BAR_WORDS_C * 4 <= CTL_BYTES, "ctl");
static_assert(WS_ACT + (size_t)MT * FF * 2 <= WS_END, "act inside the mixer region");

constexpr int LDS_BYTES = 132096;

struct Params { const float* in[31]; float* out; unsigned char* ws; int ph_lo, ph_hi; };

__device__ __forceinline__ int opq_tid() { int t = threadIdx.x; asm volatile("" : "+v"(t)); return t; }
__device__ __forceinline__ int opq_bid() { int b = blockIdx.x; asm volatile("" : "+s"(b)); return b; }
__device__ __forceinline__ float fast_exp2(float x) { return __builtin_amdgcn_exp2f(x); }
__device__ __forceinline__ float fadd_s(float a, float b) { float r; asm("v_add_f32_e32 %0, %1, %2" : "=v"(r) : "v"(a), "v"(b)); return r; }
__device__ __forceinline__ float fsub_s(float a, float b) { float r; asm("v_sub_f32_e32 %0, %1, %2" : "=v"(r) : "v"(a), "v"(b)); return r; }
__device__ __forceinline__ float fmul_s(float a, float b) { float r; asm("v_mul_f32_e32 %0, %1, %2" : "=v"(r) : "v"(a), "v"(b)); return r; }
typedef float f32x2c __attribute__((ext_vector_type(2))); typedef __bf16 bf16x2c __attribute__((ext_vector_type(2)));
__device__ __forceinline__ unsigned cvtpk_c(float lo, float hi) { f32x2c v = {lo, hi}; bf16x2c b = __builtin_convertvector(v, bf16x2c); return __builtin_bit_cast(unsigned, b); }
__device__ __forceinline__ u32x4 pack8_c(const f32x4 a, const f32x4 b) {
    u32x4 w; w.x = cvtpk_c(a[0], a[1]); w.y = cvtpk_c(a[2], a[3]); w.z = cvtpk_c(b[0], b[1]); w.w = cvtpk_c(b[2], b[3]); return w;
}
__device__ __forceinline__ float max3f(float a, float b, float c) { float r; asm("v_max3_f32 %0, %1, %2, %3" : "=v"(r) : "v"(a), "v"(b), "v"(c)); return r; }
__device__ __forceinline__ float wave_sum(float v) {
#pragma unroll
    for (int o = 32; o > 0; o >>= 1) v += __shfl_xor(v, o);
    return v;
}
__device__ __forceinline__ float rs_from(const float* p, int n4, float inv_n) {
    float s = 0.f;
    for (int i = 0; i < n4; ++i) { const f32x4 v = *(const f32x4*)(p + 4 * i); s += (v[0] + v[1]) + (v[2] + v[3]); }
    return rsqrtf(s * inv_n + EPS);
}
__device__ __forceinline__ void unpack8(const u32x4 w, f32x4& a, f32x4& b) {
    a[0] = __uint_as_float(w.x << 16); a[1] = __uint_as_float(w.x & 0xffff0000u); a[2] = __uint_as_float(w.y << 16); a[3] = __uint_as_float(w.y & 0xffff0000u);
    b[0] = __uint_as_float(w.z << 16); b[1] = __uint_as_float(w.z & 0xffff0000u); b[2] = __uint_as_float(w.w << 16); b[3] = __uint_as_float(w.w & 0xffff0000u);
}
__device__ __forceinline__ void st_nt(float* p, const f32x4 v) { __builtin_nontemporal_store(v, (f32x4*)p); }
__device__ __forceinline__ f32x4 ld_nt(const float* p) { return __builtin_nontemporal_load((const f32x4*)p); }
__device__ __forceinline__ u32x4 pack8(const f32x4 a, const f32x4 b) {
    u32x4 w; w.x = cvt_pk_bf16(a[0], a[1]); w.y = cvt_pk_bf16(a[2], a[3]); w.z = cvt_pk_bf16(b[0], b[1]); w.w = cvt_pk_bf16(b[2], b[3]); return w;
}

typedef const f32x4 (&AccRef)[2][2][4][2];

struct EpiSwiglu { static constexpr int ID = 0;
    static constexpr bool PERM = true, AFTER_DRAIN = false;
    bf16_t* act; const float* ssp;
    __device__ __forceinline__ void operator()(AccRef acc, const pg8::Unit& u, int wr, int wc, int fr, int fq) const {
        const int row0 = u.pm * 256 + wr * 64 + fr, col0 = u.pn * 128 + wc * 32 + 8 * fq;
#pragma unroll
        for (int ai = 0; ai < 2; ++ai)
#pragma unroll
            for (int m = 0; m < 4; ++m) {
                const int row = row0 + ai * 128 + m * 16;
                const float rs = rs_from(ssp + (size_t)row * 16, 4, 1.0f / 1024.0f);
                f32x4 o[2];
#pragma unroll
                for (int n = 0; n < 2; ++n)
#pragma unroll
                    for (int j = 0; j < 4; ++j) {
                        const float g = acc[ai][0][m][n][j] * rs, up = acc[ai][1][m][n][j] * rs;
                        o[n][j] = g * __builtin_amdgcn_rcpf(1.0f + __expf(-g)) * up;
                    }
                *(u32x4*)(act + (size_t)row * FF + col0) = pack8(o[0], o[1]);
            }
    }
};

struct EpiResid { static constexpr int ID = 1;
    static constexpr bool PERM = true, AFTER_DRAIN = false;
    float* x; bf16_t* xb; float* ssp; float alpha;
    __device__ __forceinline__ void operator()(AccRef acc, const pg8::Unit& u, int wr, int wc, int fr, int fq) const {
        const int row0 = u.pm * 256 + wr * 64 + fr, col0 = u.pn * 256 + wc * 32 + 8 * fq;
#pragma unroll
        for (int ai = 0; ai < 2; ++ai)
#pragma unroll
            for (int m = 0; m < 4; ++m) {
                const int row = row0 + ai * 128 + m * 16; float ss = 0.f;
#pragma unroll
                for (int bj = 0; bj < 2; ++bj) {
                    bf16_t* xp = xb + (size_t)row * D + col0 + bj * 128;
                    f32x4 a, b; unpack8(*(const u32x4*)xp, a, b);
                    a += acc[ai][bj][m][0] * alpha; b += acc[ai][bj][m][1] * alpha;
                    *(u32x4*)xp = pack8(a, b);
                    ss += (a[0] * a[0] + a[1] * a[1]) + (a[2] * a[2] + a[3] * a[3]) + (b[0] * b[0] + b[1] * b[1]) + (b[2] * b[2] + b[3] * b[3]);
                }
                ss += __shfl_xor(ss, 16); ss += __shfl_xor(ss, 32);
                if (fq == 0) ssp[(size_t)row * 16 + u.pn * 4 + wc] = ss;
            }
    }
};

struct EpiIn0 { static constexpr int ID = 2;
    static constexpr bool PERM = true, AFTER_DRAIN = false;
    const float* ssp; unsigned char* ws; float* out;
    __device__ __forceinline__ void operator()(AccRef acc, const pg8::Unit& u, int wr, int wc, int fr, int fq) const {
        const int sec = u.pn >> 1;
        const int row0 = u.pm * 256 + wr * 64 + fr, cs0 = (u.pn & 1) * 256 + wc * 32 + 8 * fq;
        const bool sample = (u.pm == 128);
        bf16_t* tok = (bf16_t*)(ws + WS_QA + (size_t)sec * QKV_SZ);
        const float qs = (sec == 0 || sec == 3) ? QS_AB : 1.0f;
#pragma unroll
        for (int ai = 0; ai < 2; ++ai)
#pragma unroll
            for (int m = 0; m < 4; ++m) {
                const int row = row0 + ai * 128 + m * 16;
                const float rs = rs_from(ssp + (size_t)row * 16, 4, 1.0f / 1024.0f);
                const float sc = rs * qs;
#pragma unroll
                for (int bj = 0; bj < 2; ++bj) {
                    const int cs = cs0 + bj * 128;
                    const f32x4 a = acc[ai][bj][m][0] * sc, b = acc[ai][bj][m][1] * sc;
                    const u32x4 w = pack8(a, b);
                    *(u32x4*)(tok + (size_t)row * 512 + cs) = w;
                    if (sec == 0 || sec == 3) continue;
                    float* fo = nullptr;
                    if (!sample) {
                        const int b_ = row >> 11, t = row & 2047;
                        if (sec == 1 || sec == 2) { if ((u.pm & 7) >= 6) fo = out + (sec == 1 ? O_PAK : O_PAV) + ((size_t)b_ * 512 + (t - 1536)) * 512 + cs; }
                        else fo = out + (sec == 4 ? O_PBK : O_PBV) + (size_t)row * 512 + cs;
                    } else {
                        const int sr = row - TP, b_ = sr >> 4, t = sr & 15;
                        const size_t so = (sec == 1) ? O_SAK : (sec == 2) ? O_SAV : (sec == 4) ? O_SBK : O_SBV;
                        fo = out + so + (size_t)sr * 512 + cs;
                        bf16_t* cat = (sec == 1) ? (bf16_t*)(ws + WS_KAS) + ((size_t)b_ * KA_ROWS + 512 + t) * 512
                                    : (sec == 2) ? (bf16_t*)(ws + WS_VAS) + ((size_t)b_ * KA_ROWS + 512 + t) * 512
                                    : (sec == 4) ? (bf16_t*)(ws + WS_KBS) + ((size_t)b_ * KB_ROWS + 1024 + t) * 512
                                                 : (bf16_t*)(ws + WS_VBS) + ((size_t)b_ * KB_ROWS + 1024 + t) * 512;
                        *(u32x4*)(cat + cs) = w;
                    }
                    if (fo) { st_nt(fo, a); st_nt(fo + 4, b); }
                }
            }
    }
};

struct EpiIn1 { static constexpr int ID = 3;
    static constexpr bool PERM = true, AFTER_DRAIN = false;
    const float* ssp; unsigned char* ws; float* out;
    __device__ __forceinline__ void operator()(AccRef acc, const pg8::Unit& u, int wr, int wc, int fr, int fq) const {
        const int row0 = u.pm * 256 + wr * 64 + fr;
        const bool sample = (u.pm == 128);
        bf16_t* cq = (bf16_t*)(ws + WS_CQ); float* ssc = (float*)(ws + WS_SSC);
#pragma unroll
        for (int ai = 0; ai < 2; ++ai)
#pragma unroll
            for (int m = 0; m < 4; ++m) {
                const int row = row0 + ai * 128 + m * 16;
                const float rs = rs_from(ssp + (size_t)row * 16, 4, 1.0f / 1024.0f);
#pragma unroll
                for (int bj = 0; bj < 2; ++bj) {
                    const int c = u.pn * 256 + bj * 128 + wc * 32 + 8 * fq;
                    const f32x4 a = acc[ai][bj][m][0] * rs, b = acc[ai][bj][m][1] * rs;
                    float ss = (a[0] * a[0] + a[1] * a[1]) + (a[2] * a[2] + a[3] * a[3]) + (b[0] * b[0] + b[1] * b[1]) + (b[2] * b[2] + b[3] * b[3]);
                    ss += __shfl_xor(ss, 16); ss += __shfl_xor(ss, 32);
                    const int part = u.pn * 2 + bj;
                    if (part < 5 && fq == 0) ssc[(size_t)row * 24 + part * 4 + wc] = ss;
                    if (part < 3) { *(u32x4*)(cq + (size_t)row * 384 + c) = pack8(a, b); }
                    else if (part < 5) {
                        float* fo = sample ? out + O_SCKV + (size_t)(row - TP) * 256 + (c - 384) : out + O_PCKV + (size_t)row * 256 + (c - 384);
                        *(f32x4*)fo = a; *(f32x4*)(fo + 4) = b;
                    } else if (wc == 0) {
                        float* fo = sample ? out + O_SCKR + (size_t)(row - TP) * 32 + (c - 640) : out + O_PCKR + (size_t)row * 32 + (c - 640);
                        *(f32x4*)fo = a; *(f32x4*)(fo + 4) = b;
                    }
                }
            }
    }
};

struct EpiQup { static constexpr int ID = 4;
    static constexpr bool PERM = true, AFTER_DRAIN = false;
    unsigned char* ws;
    __device__ __forceinline__ void operator()(AccRef acc, const pg8::Unit& u, int wr, int wc, int fr, int fq) const {
        const int row0 = u.pm * 256 + wr * 64 + fr;
        const float* ssc = (const float*)(ws + WS_SSC); bf16_t* qc = (bf16_t*)(ws + WS_QC); const float* rope = (const float*)(ws + WS_ROPE);
#pragma unroll
        for (int ai = 0; ai < 2; ++ai)
#pragma unroll
            for (int m = 0; m < 4; ++m) {
                const int row = row0 + ai * 128 + m * 16;
                const float rs = rs_from(ssc + (size_t)row * 24, 3, 1.0f / 384.0f) * QS_C;
                const int pos = row < TP ? (row & 2047) : PAST + ((row - TP) & 15);
#pragma unroll
                for (int bj = 0; bj < 2; ++bj) {
                    const int c = u.pn * 256 + bj * 128 + wc * 32 + 8 * fq;
                    const int o = c % 96;
                    f32x4 a = acc[ai][bj][m][0] * rs, b = acc[ai][bj][m][1] * rs;
                    if (o >= 64) {
                        const int i0 = (o - 64) >> 1;
                        const f32x4 cs0 = *(const f32x4*)(rope + ((size_t)pos * 16 + i0) * 2), cs1 = *(const f32x4*)(rope + ((size_t)pos * 16 + i0 + 2) * 2);
                        f32x4 a2, b2;
                        a2[0] = a[0] * cs0[0] - a[1] * cs0[1]; a2[1] = a[0] * cs0[1] + a[1] * cs0[0];
                        a2[2] = a[2] * cs0[2] - a[3] * cs0[3]; a2[3] = a[2] * cs0[3] + a[3] * cs0[2];
                        b2[0] = b[0] * cs1[0] - b[1] * cs1[1]; b2[1] = b[0] * cs1[1] + b[1] * cs1[0];
                        b2[2] = b[2] * cs1[2] - b[3] * cs1[3]; b2[3] = b[2] * cs1[3] + b[3] * cs1[2];
                        a = a2; b = b2;
                    }
                    *(u32x4*)(qc + (size_t)row * 1536 + c) = pack8(a, b);
                }
            }
    }
};

constexpr int KC_ROWS = 1040;
constexpr size_t KVC_S_OFF = (size_t)NB * 16 * SEQ * 128;
struct EpiKvHead { static constexpr int ID = 6;
    static constexpr bool PERM = true, AFTER_DRAIN = false;
    bf16_t* O;
    __device__ __forceinline__ void operator()(AccRef acc, const pg8::Unit& u, int wr, int wc, int fr, int fq) const {
        const int row0 = u.pm * 256 + wr * 64 + fr, col0 = u.pn * 256 + wc * 32 + 8 * fq;
        asm volatile("s_nop 15" ::: "memory");
#pragma unroll
        for (int ai = 0; ai < 2; ++ai)
#pragma unroll
            for (int m = 0; m < 4; ++m) {
                const int row = row0 + ai * 128 + m * 16; size_t base; long stride;
                if (row < TP) { base = ((size_t)(row >> 11) * 16 * SEQ + (row & 2047)) * 128; stride = (long)SEQ * 128; }
                else { const int sr = row - TP, b_ = sr / (PAST + NEW), pos = sr - b_ * (PAST + NEW); base = KVC_S_OFF + ((size_t)b_ * 16 * KC_ROWS + pos) * 128; stride = (long)KC_ROWS * 128; }
#pragma unroll
                for (int bj = 0; bj < 2; ++bj) { const int c = col0 + bj * 128;
                    *(u32x4*)(O + base + (size_t)(c >> 7) * stride + (c & 127)) = pack8_c(acc[ai][bj][m][0], acc[ai][bj][m][1]); }
            }
    }
};
struct EpiPlain { static constexpr int ID = 5;
    static constexpr bool PERM = true, AFTER_DRAIN = false;
    bf16_t* O; int ldc;
    __device__ __forceinline__ void operator()(AccRef acc, const pg8::Unit& u, int wr, int wc, int fr, int fq) const {
        const int row0 = u.pm * 256 + wr * 64 + fr, col0 = u.pn * 256 + wc * 32 + 8 * fq;
#pragma unroll
        for (int ai = 0; ai < 2; ++ai)
#pragma unroll
            for (int m = 0; m < 4; ++m)
#pragma unroll
                for (int bj = 0; bj < 2; ++bj)
                    *(u32x4*)(O + (size_t)(row0 + ai * 128 + m * 16) * ldc + col0 + bj * 128) = pack8_c(acc[ai][bj][m][0], acc[ai][bj][m][1]);
    }
};

template <class Epi> __device__ __forceinline__ void run_gemm(LAS unsigned char* lds, const bf16_t* A, const bf16_t* Bt, int M, int N, int K, const Epi& E) {
    asm volatile("" : "+s"(K));
    pg8::Gemm g{A, Bt, M, N, K}; pg8::StaticOrder S; S.init(M, N, (int)gridDim.x, (int)blockIdx.x);
#ifdef ONLY_G
    if constexpr (Epi::ID != ONLY_G) return;
#endif
#ifndef DIS_G
    pg8::gemm_phase<Epi, pg8::StaticOrder, true, true>(lds, g, S, E);
#endif
}


template <int NG, int UNR, class Epi, int KS = 1> __device__ __forceinline__ void skinny_gemm(const bf16_t* A, const bf16_t* Bt, int K, int ngroups, const Epi& E, int bshift = 0, LAS unsigned char* lds = nullptr) {
    static_assert(KS == 1 || KS == 2 || KS == 4, "KS");
    constexpr int NRG = 8 / KS;
    const int tid = opq_tid(), lane = tid & 63, w = tid >> 6, rr = lane & 15, kq = lane >> 4;
    const int rg = w & (NRG - 1), kh = KS == 1 ? 0 : (w >> (KS == 4 ? 1 : 2)), KL = K / KS;
    for (int u = (opq_bid() + (int)gridDim.x - bshift) % (int)gridDim.x; u < 2 * KS * ngroups; u += gridDim.x) {
        const int hv = u & (2 * KS - 1), cg = u / (2 * KS), srow = hv * (128 / KS) + rg * 16 + rr;
        const bf16_t* ap = A + (size_t)srow * K + kh * KL + 8 * kq;
        const bf16_t* bp[NG]; f32x4 acc[NG];
#pragma unroll
        for (int g = 0; g < NG; ++g) { bp[g] = Bt + (size_t)(Epi::brow(cg, g) + rr) * K + kh * KL + 8 * kq; acc[g] = (f32x4){0.f, 0.f, 0.f, 0.f}; }
        bf16x8 a0[UNR], a1[UNR], b0[NG][UNR], b1[NG][UNR];
#define SK_LOAD(AR, BR, k0) do { _Pragma("unroll") for (int i = 0; i < UNR; ++i) { AR[i] = *(const bf16x8*)(ap + (k0) + 32 * i); \
            _Pragma("unroll") for (int g = 0; g < NG; ++g) BR[g][i] = *(const bf16x8*)(bp[g] + (k0) + 32 * i); } } while (0)
#define SK_MMA(AR, BR) do { _Pragma("unroll") for (int i = 0; i < UNR; ++i) _Pragma("unroll") for (int g = 0; g < NG; ++g) acc[g] = __builtin_amdgcn_mfma_f32_16x16x32_bf16(BR[g][i], AR[i], acc[g], 0, 0, 0); } while (0)
        SK_LOAD(a0, b0, 0);
        for (int k = 0; k < KL; k += 64 * UNR) {
            SK_LOAD(a1, b1, k + 32 * UNR);
            SK_MMA(a0, b0);
            if (k + 64 * UNR < KL) SK_LOAD(a0, b0, k + 64 * UNR);
            SK_MMA(a1, b1);
        }
#undef SK_LOAD
#undef SK_MMA
        if constexpr (KS > 1) {
            LAS f32x4* xch = (LAS f32x4*)lds;
            if (kh > 0) xch[((kh - 1) * NRG + rg) * 64 + lane] = acc[0] + (f32x4){0.f, 0.f, 0.f, 0.f};
            __syncthreads();
            if (kh == 0) {
#pragma unroll
                for (int q = 0; q < KS - 1; ++q) acc[0] += xch[(q * NRG + rg) * 64 + lane];
                E(acc, srow, cg, kq);
            }
            __syncthreads();
        } else E(acc, srow, cg, kq);
    }
}
__device__ __forceinline__ float rs_sample(const float* ssps, int srow) { return rs_from(ssps + (size_t)srow * 64, 16, 1.0f / 1024.0f); }

struct SkSwiglu { static __device__ __forceinline__ int brow(int cg, int g) { return 256 * (cg >> 3) + 16 * (cg & 7) + 128 * g; }
    bf16_t* act; const float* ssps;
    __device__ __forceinline__ void operator()(const f32x4 (&acc)[2], int srow, int cg, int kq) const {
        const float rs = rs_sample(ssps, srow); f32x4 o;
#pragma unroll
        for (int j = 0; j < 4; ++j) { const float g = acc[0][j] * rs, up = acc[1][j] * rs; o[j] = g * __builtin_amdgcn_rcpf(1.0f + __expf(-g)) * up; }
        u32x2 w; w.x = cvt_pk_bf16(o[0], o[1]); w.y = cvt_pk_bf16(o[2], o[3]);
        *(u32x2*)(act + (size_t)(TP + srow) * FF + cg * 16 + 4 * kq) = w;
    }
};
struct SkSwiglu4 { static __device__ __forceinline__ int brow(int cgp, int g) { const int cg = 2 * cgp + (g >> 1); return 256 * (cg >> 3) + 16 * (cg & 7) + 128 * (g & 1); }
    bf16_t* act; const float* ssps;
    __device__ __forceinline__ void operator()(const f32x4 (&acc)[4], int srow, int cgp, int kq) const {
        const float rs = rs_sample(ssps, srow);
#pragma unroll
        for (int q = 0; q < 2; ++q) { f32x4 o;
#pragma unroll
            for (int j = 0; j < 4; ++j) { const float g = acc[2 * q][j] * rs, up = acc[2 * q + 1][j] * rs; o[j] = g * __builtin_amdgcn_rcpf(1.0f + __expf(-g)) * up; }
            u32x2 w; w.x = cvt_pk_bf16(o[0], o[1]); w.y = cvt_pk_bf16(o[2], o[3]);
            *(u32x2*)(act + (size_t)(TP + srow) * FF + (2 * cgp + q) * 16 + 4 * kq) = w; }
    }
};
struct SkResid { static __device__ __forceinline__ int brow(int cg, int) { return 16 * cg; }
    float* x; bf16_t* xb; float* ssps; float alpha;
    __device__ __forceinline__ void operator()(const f32x4 (&acc)[1], int srow, int cg, int kq) const {
        bf16_t* xp = xb + (size_t)(TP + srow) * D + cg * 16 + 4 * kq;
        const u32x2 w0 = *(const u32x2*)xp; f32x4 a;
        a[0] = __uint_as_float(w0.x << 16); a[1] = __uint_as_float(w0.x & 0xffff0000u); a[2] = __uint_as_float(w0.y << 16); a[3] = __uint_as_float(w0.y & 0xffff0000u);
        a += acc[0] * alpha;
        u32x2 w; w.x = cvt_pk_bf16(a[0], a[1]); w.y = cvt_pk_bf16(a[2], a[3]);
        *(u32x2*)xp = w;
        float ss = (a[0] * a[0] + a[1] * a[1]) + (a[2] * a[2] + a[3] * a[3]);
        ss += __shfl_xor(ss, 16); ss += __shfl_xor(ss, 32);
        if (kq == 0) ssps[(size_t)srow * 64 + cg] = ss;
    }
};
struct SkIn0 { static __device__ __forceinline__ int brow(int cg, int) { return 16 * cg; }
    const float* ssps; unsigned char* ws; float* out;
    __device__ __forceinline__ void operator()(const f32x4 (&acc)[1], int srow, int cg, int kq) const {
        const int sec = cg >> 5, cs = (cg & 31) * 16 + 4 * kq, b_ = srow >> 4, t = srow & 15;
        const float sc = rs_sample(ssps, srow) * ((sec == 0 || sec == 3) ? QS_AB : 1.0f);
        const f32x4 a = acc[0] * sc;
        u32x2 w; w.x = cvt_pk_bf16(a[0], a[1]); w.y = cvt_pk_bf16(a[2], a[3]);
        *(u32x2*)((bf16_t*)(ws + WS_QA + (size_t)sec * QKV_SZ) + (size_t)(TP + srow) * 512 + cs) = w;
        if (sec == 0 || sec == 3) return;
        const size_t so = (sec == 1) ? O_SAK : (sec == 2) ? O_SAV : (sec == 4) ? O_SBK : O_SBV;
        *(f32x4*)(out + so + (size_t)srow * 512 + cs) = a;
        bf16_t* cat = (sec == 1) ? (bf16_t*)(ws + WS_KAS) + ((size_t)b_ * KA_ROWS + 512 + t) * 512
                    : (sec == 2) ? (bf16_t*)(ws + WS_VAS) + ((size_t)b_ * KA_ROWS + 512 + t) * 512
                    : (sec == 4) ? (bf16_t*)(ws + WS_KBS) + ((size_t)b_ * KB_ROWS + 1024 + t) * 512
                                 : (bf16_t*)(ws + WS_VBS) + ((size_t)b_ * KB_ROWS + 1024 + t) * 512;
        *(u32x2*)(cat + cs) = w;
    }
};
struct SkIn1 { static __device__ __forceinline__ int brow(int cg, int) { return 16 * cg; }
    const float* ssps; unsigned char* ws; float* out;
    __device__ __forceinline__ void operator()(const f32x4 (&acc)[1], int srow, int cg, int kq) const {
        const f32x4 a = acc[0] * rs_sample(ssps, srow);
        float ss = (a[0] * a[0] + a[1] * a[1]) + (a[2] * a[2] + a[3] * a[3]);
        ss += __shfl_xor(ss, 16); ss += __shfl_xor(ss, 32);
        if (cg < 40 && kq == 0) ((float*)(ws + WS_SSCS))[(size_t)srow * 40 + cg] = ss;
        const int c = cg * 16 + 4 * kq;
        if (cg < 24) { u32x2 w; w.x = cvt_pk_bf16(a[0], a[1]); w.y = cvt_pk_bf16(a[2], a[3]); *(u32x2*)((bf16_t*)(ws + WS_CQ) + (size_t)(TP + srow) * 384 + c) = w; }
        else if (cg < 40) *(f32x4*)(out + O_SCKV + (size_t)srow * 256 + (c - 384)) = a;
        else *(f32x4*)(out + O_SCKR + (size_t)srow * 32 + (c - 640)) = a;
    }
};
struct SkPlain { static __device__ __forceinline__ int brow(int cg, int) { return 16 * cg; }
    bf16_t* O; int ldc;
    __device__ __forceinline__ void operator()(const f32x4 (&acc)[1], int srow, int cg, int kq) const {
        u32x2 w; w.x = cvt_pk_bf16(acc[0][0], acc[0][1]); w.y = cvt_pk_bf16(acc[0][2], acc[0][3]);
        *(u32x2*)(O + (size_t)srow * ldc + cg * 16 + 4 * kq) = w;
    }
};
struct SkKvHead { static __device__ __forceinline__ int brow(int cg, int) { return 16 * cg; }
    bf16_t* O;
    __device__ __forceinline__ void operator()(const f32x4 (&acc)[1], int srow, int cg, int kq) const {
        const int sr = (MKV - 256 - TP) + srow, b_ = sr / (PAST + NEW), pos = sr - b_ * (PAST + NEW), c = cg * 16 + 4 * kq;
        u32x2 w; w.x = cvtpk_c(acc[0][0], acc[0][1]); w.y = cvtpk_c(acc[0][2], acc[0][3]);
        *(u32x2*)(O + KVC_S_OFF + (((size_t)b_ * 16 + (c >> 7)) * KC_ROWS + pos) * 128 + (c & 127)) = w;
    }
};
struct SkQup { static __device__ __forceinline__ int brow(int cg, int) { return 16 * cg; }
    unsigned char* ws;
    __device__ __forceinline__ void operator()(const f32x4 (&acc)[1], int srow, int cg, int kq) const {
        const float rs = rs_from((const float*)(ws + WS_SSCS) + (size_t)srow * 40, 6, 1.0f / 384.0f) * QS_C;
        const int c = cg * 16 + 4 * kq, o = c % 96, pos = PAST + (srow & 15);
        f32x4 a = acc[0] * rs;
        if (o >= 64) {
            const int i0 = (o - 64) >> 1;
            const f32x4 cs0 = *(const f32x4*)((const float*)(ws + WS_ROPE) + ((size_t)pos * 16 + i0) * 2);
            f32x4 a2; a2[0] = a[0] * cs0[0] - a[1] * cs0[1]; a2[1] = a[0] * cs0[1] + a[1] * cs0[0]; a2[2] = a[2] * cs0[2] - a[3] * cs0[3]; a2[3] = a[2] * cs0[3] + a[3] * cs0[2];
            a = a2;
        }
        u32x2 w; w.x = cvt_pk_bf16(a[0], a[1]); w.y = cvt_pk_bf16(a[2], a[3]);
        *(u32x2*)((bf16_t*)(ws + WS_QC) + (size_t)(TP + srow) * 1536 + c) = w;
    }
};

__device__ __forceinline__ void convert_weight(LAS unsigned char* lds, const float* W, bf16_t* Bt, int K, int Nsrc, int Ndst, const float* gain, int mode) {
    LAS float* tile = (LAS float*)lds;
    const int tid = opq_tid(), nkt = K / 64, nnt = Ndst / 64;
    for (int t = opq_bid(); t < nkt * nnt; t += gridDim.x) {
        const int k0 = (t % nkt) * 64, n0 = (t / nkt) * 64;
#pragma unroll
        for (int i = 0; i < 8; ++i) {
            const int e = tid + i * 512, kk = e >> 6, nn = e & 63, np = n0 + nn; int n;
            if (mode == 1) { const int pn = np >> 8, bj = (np >> 7) & 1, c = np & 127; n = bj * FF + pn * 128 + c; }
            else if (mode == 2) { const int h = np / 96, o = np % 96; n = o < 64 ? np : h * 96 + 64 + ((o - 64) & 1) * 16 + ((o - 64) >> 1); }
            else n = np;
            float v = 0.f;
            if (n < Nsrc) { v = W[(size_t)(k0 + kk) * Nsrc + n]; if (gain) v *= gain[k0 + kk]; }
            tile[kk * 65 + nn] = v;
        }
        __syncthreads();
#pragma unroll
        for (int i = 0; i < 4; ++i) {
            const int e = tid + i * 512, nn = e >> 5, kp = e & 31;
            *(unsigned*)(Bt + (size_t)(n0 + nn) * K + k0 + 2 * kp) = cvt_pk_bf16(tile[(2 * kp) * 65 + nn], tile[(2 * kp + 1) * 65 + nn]);
        }
        __syncthreads();
    }
}


__device__ __forceinline__ void convert_weight_v4(LAS unsigned char* lds, const float* W, bf16_t* Bt, int K, int Nsrc, int Ndst, const float* gain, int mode) {
    LAS float* tile = (LAS float*)lds;
    const int tid = opq_tid(), nkt = K / 64, nnt = Ndst / 256;
    for (int t = opq_bid(); t < nkt * nnt; t += gridDim.x) {
        const int k0 = (t % nkt) * 64, pn = t / nkt, n0 = pn * 256;
        f32x4 v[8];
#pragma unroll
        for (int i = 0; i < 8; ++i) {
            const int e = tid + i * 512, kk = e >> 6, n4 = e & 63;
            const int n = (mode == 1) ? (n4 >> 5) * FF + pn * 128 + (n4 & 31) * 4 : n0 + n4 * 4;
            v[i] = (f32x4){0.f, 0.f, 0.f, 0.f};
            if (n < Nsrc) v[i] = ld_nt(W + (size_t)(k0 + kk) * Nsrc + n);
        }
#pragma unroll
        for (int i = 0; i < 8; ++i) {
            const int e = tid + i * 512, kk = e >> 6, n4 = e & 63;
            const float g = gain ? gain[k0 + kk] : 1.0f;
#pragma unroll
            for (int j = 0; j < 4; ++j) tile[kk * 257 + n4 * 4 + j] = v[i][j] * g;
        }
        __syncthreads();
#pragma unroll
        for (int i = 0; i < 8; ++i) {
            const int e = tid + i * 512, nn = e >> 4, kq = e & 15;
            u32x2 w; w.x = cvt_pk_bf16(tile[(4 * kq) * 257 + nn], tile[(4 * kq + 1) * 257 + nn]); w.y = cvt_pk_bf16(tile[(4 * kq + 2) * 257 + nn], tile[(4 * kq + 3) * 257 + nn]);
            *(u32x2*)(Bt + (size_t)(n0 + nn) * K + k0 + 4 * kq) = w;
        }
        __syncthreads();
    }
}

__device__ __forceinline__ void convert_rows(const float* src, bf16_t* dst, int R, int W, int per, int stride, int off, int vb = -1, int nb = 0) {
    if (vb < 0) { vb = opq_bid(); nb = (int)gridDim.x; }
    const int cpr = W / 8; const long total = (long)R * cpr, step = (long)nb * 512;
    for (long c0 = (long)vb * 512 + opq_tid(); c0 < total; c0 += 4 * step) {
        f32x4 a[4], b[4];
#pragma unroll
        for (int q = 0; q < 4; ++q) { const long c = c0 + q * step; if (c < total) { const long r = c / cpr; const int c8 = (int)(c % cpr);
            a[q] = ld_nt(src + (size_t)r * W + c8 * 8); b[q] = ld_nt(src + (size_t)r * W + c8 * 8 + 4); } }
#pragma unroll
        for (int q = 0; q < 4; ++q) { const long c = c0 + q * step; if (c < total) { const int r = (int)(c / cpr), c8 = (int)(c % cpr);
            const size_t dr = (size_t)(r / per) * stride + off + (r % per);
            *(u32x4*)(dst + dr * W + c8 * 8) = pack8(a[q], b[q]); } }
    }
}

__device__ __forceinline__ void prologue(LAS unsigned char* lds, const Params& P) {
    unsigned char* ws = P.ws; const float* const* in = P.in;
    const int tid = opq_tid(), lane = tid & 63, gw = opq_bid() * 8 + (tid >> 6), nw = gridDim.x * 8;
    for (int l = 0; l < 2; ++l) {
        convert_weight_v4(lds, in[10] + (size_t)l * D * 2 * FF, (bf16_t*)(ws + W_GU + (size_t)(l * 2 + 0) * W_GU_SZ), D, 2 * FF, 2 * FF, in[9] + l * D, 1);
        convert_weight_v4(lds, in[14] + (size_t)l * D * 2 * FF, (bf16_t*)(ws + W_GU + (size_t)(l * 2 + 1) * W_GU_SZ), D, 2 * FF, 2 * FF, in[13] + l * D, 1);
        convert_weight_v4(lds, in[11] + (size_t)l * FF * D, (bf16_t*)(ws + W_DN + (size_t)(l * 2 + 0) * W_DN_SZ), FF, D, D, nullptr, 0);
        convert_weight_v4(lds, in[15] + (size_t)l * FF * D, (bf16_t*)(ws + W_DN + (size_t)(l * 2 + 1) * W_DN_SZ), FF, D, D, nullptr, 0);
    }
    convert_weight_v4(lds, in[16], (bf16_t*)(ws + W_IN0), D, 3072, 3072, in[12], 0);
    convert_weight_v4(lds, in[23], (bf16_t*)(ws + W_OUT0), D, D, D, nullptr, 0);
    convert_weight_v4(lds, in[24], (bf16_t*)(ws + W_IN1), D, 672, 768, in[12] + D, 0);
    convert_weight(lds, in[27], (bf16_t*)(ws + W_QUP), 384, 1536, 1536, in[25], 2);
    convert_weight_v4(lds, in[28], (bf16_t*)(ws + W_KVUP), 256, 2048, 2048, nullptr, 0);
    convert_weight_v4(lds, in[29], (bf16_t*)(ws + W_OUT1), D, D, D, nullptr, 0);
    {
        bf16_t* xb = (bf16_t*)(ws + WS_XB); float* ssp = (float*)(ws + WS_SSP);
        for (int row0 = gw * 2; row0 < MT; row0 += nw * 2) {
            f32x4 a[2][2], b[2][2];
#pragma unroll
            for (int q = 0; q < 2; ++q) { const int row = row0 + q; const float* src = row < TP ? in[0] + (size_t)row * D : in[1] + (size_t)(row - TP) * D;
#pragma unroll
                for (int i = 0; i < 2; ++i) { const int c = (lane + i * 64) * 8; a[q][i] = ld_nt(src + c); b[q][i] = ld_nt(src + c + 4); } }
#pragma unroll
            for (int q = 0; q < 2; ++q) { const int row = row0 + q; float ss = 0.f;
#pragma unroll
                for (int i = 0; i < 2; ++i) { const int c = (lane + i * 64) * 8; const f32x4 av = a[q][i], bv = b[q][i];
                    *(u32x4*)(xb + (size_t)row * D + c) = pack8(av, bv);
                    ss += (av[0] * av[0] + av[1] * av[1]) + (av[2] * av[2] + av[3] * av[3]) + (bv[0] * bv[0] + bv[1] * bv[1]) + (bv[2] * bv[2] + bv[3] * bv[3]); }
                ss = wave_sum(ss);
                if (lane < 16) ssp[(size_t)row * 16 + lane] = lane == 0 ? ss : 0.f;
                if (row >= TP) ((float*)(ws + WS_SSPS))[(size_t)(row - TP) * 64 + lane] = lane == 0 ? ss : 0.f; }
        }
    }
    convert_rows(in[2], (bf16_t*)(ws + WS_KAS), NB * 512, 512, 512, KA_ROWS, 0);
    convert_rows(in[3], (bf16_t*)(ws + WS_VAS), NB * 512, 512, 512, KA_ROWS, 0);
    convert_rows(in[4], (bf16_t*)(ws + WS_KBS), NB * 1024, 512, 1024, KB_ROWS, 0);
    convert_rows(in[5], (bf16_t*)(ws + WS_VBS), NB * 1024, 512, 1024, KB_ROWS, 0);
    {
        float* rope = (float*)(ws + WS_ROPE);
        for (int e = opq_bid() * 512 + tid; e < 2048 * 16; e += gridDim.x * 512) {
            const int pos = e >> 4, i = e & 15;
            const float inv = expf(-(float)i * (9.210340371976184f / 16.0f));
            const float ang = (float)pos * inv;
            const float k = rintf(ang * 0.15915494309189535f);
            float r = fmaf(-k, 6.28125f, ang); r = fmaf(-k, 1.9353071795864769e-3f, r);
            rope[2 * e] = __cosf(r); rope[2 * e + 1] = __sinf(r);
        }
    }
}

__device__ __forceinline__ void prologue_l1(const Params& P, int vb, int nb) {
    unsigned char* ws = P.ws;
    convert_rows(P.in[6], (bf16_t*)(ws + WS_CKVN), NB * 1024, 256, 1024, PAST + NEW, TP, vb, nb);
    bf16_t* krb = (bf16_t*)(ws + WS_KRB); const float* src = P.in[7];
    for (long c = (long)vb * 512 + opq_tid(); c < (long)NB * 1024 * 4; c += (long)nb * 512) {
        const int r = (int)(c >> 2), c8 = (int)(c & 3);
        const f32x4 a = *(const f32x4*)(src + (size_t)r * 32 + c8 * 4), b = *(const f32x4*)(src + (size_t)r * 32 + 16 + c8 * 4);
        const size_t dr = (size_t)TP + (size_t)(r >> 10) * (PAST + NEW) + (r & 1023);
        u32x4 w; w.x = cvt_pk_bf16(a[0], b[0]); w.y = cvt_pk_bf16(a[1], b[1]); w.z = cvt_pk_bf16(a[2], b[2]); w.w = cvt_pk_bf16(a[3], b[3]);
        *(u32x4*)(krb + dr * 32 + c8 * 8) = w;
    }
}

__device__ __forceinline__ void thin_l1(const Params& P) {
    unsigned char* ws = P.ws;
    const int tid = opq_tid(), lane = tid & 63, gw = opq_bid() * 8 + (tid >> 6), nw = gridDim.x * 8;
    const float* ssc = (const float*)(ws + WS_SSC); const float* gkv = P.in[26]; const float* rope = (const float*)(ws + WS_ROPE);
    bf16_t* ckvn = (bf16_t*)(ws + WS_CKVN); bf16_t* krb = (bf16_t*)(ws + WS_KRB);
    const f32x4 g = *(const f32x4*)(gkv + lane * 4);
    for (int row = gw; row < MT; row += nw) {
        const bool sample = row >= TP; const int sr = row - TP;
        float* ckv = sample ? P.out + O_SCKV + (size_t)sr * 256 : P.out + O_PCKV + (size_t)row * 256;
        float* kr = sample ? P.out + O_SCKR + (size_t)sr * 32 : P.out + O_PCKR + (size_t)row * 32;
        const size_t dr = sample ? (size_t)TP + (size_t)(sr >> 4) * (PAST + NEW) + PAST + (sr & 15) : (size_t)row;
        const int pos = sample ? PAST + (sr & 15) : (row & 2047);
        const float rs = sample ? rs_from((const float*)(ws + WS_SSCS) + (size_t)sr * 40 + 24, 4, 1.0f / 256.0f) : rs_from(ssc + (size_t)row * 24 + 12, 2, 1.0f / 256.0f);
        f32x4 v = *(const f32x4*)(ckv + lane * 4); v = v * rs * g;
        *(f32x4*)(ckv + lane * 4) = v;
        u32x2 w; w.x = cvt_pk_bf16(v[0], v[1]); w.y = cvt_pk_bf16(v[2], v[3]);
        *(u32x2*)(ckvn + dr * 256 + lane * 4) = w;
        if (lane < 16) {
            const float x1 = kr[lane], x2 = kr[16 + lane];
            const float c = rope[((size_t)pos * 16 + lane) * 2], s = rope[((size_t)pos * 16 + lane) * 2 + 1];
            const float y1 = x1 * c - x2 * s, y2 = x1 * s + x2 * c;
            kr[lane] = y1; kr[16 + lane] = y2;
            *(unsigned*)(krb + dr * 32 + 2 * lane) = cvt_pk_bf16(y1, y2);
        }
    }
}

__device__ __forceinline__ void final_norm(const Params& P) {
    const int tid = opq_tid(), lane = tid & 63, gw = opq_bid() * 8 + (tid >> 6), nw = gridDim.x * 8;
    const float* ssp = (const float*)(P.ws + WS_SSP); const float* g = P.in[30]; float* x = P.out; const bf16_t* xbf = (const bf16_t*)(P.ws + WS_XB);
    for (int row = gw; row < MT; row += nw) {
        const float rs = row >= TP ? rs_sample((const float*)(P.ws + WS_SSPS), row - TP) : rs_from(ssp + (size_t)row * 16, 4, 1.0f / 1024.0f);
#pragma unroll
        for (int i = 0; i < 2; ++i) {
            const int c = (lane + i * 64) * 8;
            f32x4 a, b; unpack8(*(const u32x4*)(xbf + (size_t)row * D + c), a, b);
            const f32x4 g0 = *(const f32x4*)(g + c), g1 = *(const f32x4*)(g + c + 4);
            st_nt(x + (size_t)row * D + c, a * rs * g0); st_nt(x + (size_t)row * D + c + 4, b * rs * g1);
        }
    }
}

struct KVSrc { const bf16_t* k; long kp; const bf16_t* k2; long k2p; const bf16_t* v; long vp; };
typedef short v4i16_t __attribute__((ext_vector_type(4)));
__device__ __forceinline__ s16x4 vtr(const LAS unsigned char* p) { return __builtin_bit_cast(s16x4, __builtin_amdgcn_ds_read_tr16_b64_v4i16((LAS v4i16_t*)p)); }

constexpr int ATT_TAB = 0, ATT_BUF = 1024;

template <int DQK, int DV, bool BIAS, int TK>
__device__ __forceinline__ void flash_pass(LAS unsigned char* lds, const KVSrc& S, int uc0, int uc1, int wc0, int wc1, int nkeys,
                                           const bf16x8 (&qf)[DQK / 16], int qpos, int qpos_w0, int kpos0, f32x16 (&o)[DV / 32], float& m_run, float& l_run) {
    constexpr int KP = DQK * 2 + 16, VP = DV * 2 + 64, KBUF = TK * KP, VBUF = TK * VP, KCH = DQK / 8, VCH = DV / 8, NKI = TK * KCH / 512, NVI = TK * VCH / 512, NPB = TK / 32, NST = TK / 16;
    static_assert((TK == 64 || TK == 128) && TK * KCH % 512 == 0 && TK * VCH % 512 == 0 && ATT_BUF + 2 * (KBUF + VBUF) <= 131072, "attention tile geometry");
    const int tid = opq_tid(), lane = tid & 63, l31 = lane & 31, hi = lane >> 5;
    LAS unsigned char* kb0 = lds + ATT_BUF; LAS unsigned char* vb0 = lds + ATT_BUF + 2 * KBUF;
    const LAS float* tab = (const LAS float*)(lds + ATT_TAB);
    const int t0 = (uc0 * 64) / TK, t1 = (uc1 * 64 + TK - 1) / TK;
    if (t0 >= t1) return;
    const int klo = 64 * wc0, khi = (64 * wc1 < nkeys) ? 64 * wc1 : nkeys;
    const int w0 = klo / TK, w1 = khi > klo ? (khi + TK - 1) / TK : w0;
    u32x4 kreg[NKI], vreg[NVI];
#define ATT_LOAD(t) do { \
        _Pragma("unroll") for (int i = 0; i < NKI; ++i) { const int c = tid + i * 512; const int r = c / KCH, cc = c % KCH; const long kr = (long)(t) * TK + r; \
            const bf16_t* src = (DQK == 96 && cc >= 8) ? S.k2 + kr * S.k2p + (cc - 8) * 8 : S.k + kr * S.kp + cc * 8; kreg[i] = *(const u32x4*)src; } \
        _Pragma("unroll") for (int i = 0; i < NVI; ++i) { const int c = tid + i * 512; const int r = c / VCH, cc = c % VCH; vreg[i] = *(const u32x4*)(S.v + ((long)(t) * TK + r) * S.vp + cc * 8); } } while (0)
#define ATT_STORE(b) do { \
        _Pragma("unroll") for (int i = 0; i < NKI; ++i) { const int c = tid + i * 512; const int r = c / KCH, cc = c % KCH; *(LAS u32x4*)(kb0 + (b) * KBUF + r * KP + cc * 16) = kreg[i]; } \
        _Pragma("unroll") for (int i = 0; i < NVI; ++i) { const int c = tid + i * 512; const int r = c / VCH, cc = c % VCH; *(LAS u32x4*)(vb0 + (b) * VBUF + r * VP + cc * 16) = vreg[i]; } } while (0)
    ATT_LOAD(t0); ATT_STORE(0); __syncthreads();
    const int koff = l31 * KP + hi * 16;
    const int voff = (4 * hi + ((lane & 15) >> 2)) * VP + (16 * ((lane >> 4) & 1) + 4 * (lane & 3)) * 2;
    for (int t = t0; t < t1; ++t) {
        const int cur = (t - t0) & 1;
        ATT_LOAD((t + 1 < t1 ? t + 1 : t1 - 1));
        if (t >= w0 && t < w1) {
            const LAS unsigned char* kb = kb0 + cur * KBUF + koff; const LAS unsigned char* vb = vb0 + cur * VBUF + voff;
            f32x16 p[NPB];
#pragma unroll
            for (int q = 0; q < NPB; ++q)
#pragma unroll
                for (int r = 0; r < 16; ++r) p[q][r] = 0.f;
#pragma unroll
            for (int ks = 0; ks < DQK / 16; ++ks)
#pragma unroll
                for (int q = 0; q < NPB; ++q) {
                    const bf16x8 a = *(const LAS bf16x8*)(kb + q * 32 * KP + ks * 32);
                    p[q] = __builtin_amdgcn_mfma_f32_32x32x16_bf16(a, qf[ks], p[q], 0, 0, 0);
                }
            __builtin_amdgcn_sched_barrier(0);
            asm volatile("s_nop 15\n\ts_nop 15" ::: "memory");
            const int tk0 = t * TK;
            if (BIAS) {
                const int tkpos = kpos0 + tk0;
                if (qpos_w0 - (tkpos + TK - 64) >= 192) { const float c = tab[254];
#pragma unroll
                    for (int q = 0; q < NPB; ++q)
#pragma unroll
                        for (int r = 0; r < 16; ++r) p[q][r] += c; }
                else { const int base = qpos - (tkpos + 4 * hi) + 63;
#pragma unroll
                    for (int q = 0; q < NPB; ++q)
#pragma unroll
                        for (int r = 0; r < 16; ++r) { int i0 = base - ((r & 3) + 8 * (r >> 2)) - 32 * q; i0 = i0 > 254 ? 254 : i0; p[q][r] += tab[i0]; } }
            }
            if (tk0 < klo || tk0 + TK > khi) {
                asm volatile("" ::: "memory");
#pragma unroll
                for (int q = 0; q < NPB; ++q)
#pragma unroll
                    for (int r = 0; r < 16; ++r) { const int key = tk0 + 32 * q + 4 * hi + (r & 3) + 8 * (r >> 2); if (key < klo || key >= khi) p[q][r] = NEGBIG; }
            }
            float mxa = max3f(p[0][0], p[0][1], p[1][0]), mxb = max3f(p[0][2], p[0][3], p[1][1]); mxa = max3f(mxa, p[1][2], p[1][3]);
#pragma unroll
            for (int r = 4; r < 16; r += 4) { mxa = max3f(mxa, p[0][r], p[0][r + 1]); mxb = max3f(mxb, p[0][r + 2], p[0][r + 3]); mxa = max3f(mxa, p[1][r], p[1][r + 1]); mxb = max3f(mxb, p[1][r + 2], p[1][r + 3]); }
            if constexpr (NPB == 4) {
#pragma unroll
                for (int r = 0; r < 16; r += 4) { mxa = max3f(mxa, p[2][r], p[2][r + 1]); mxb = max3f(mxb, p[2][r + 2], p[2][r + 3]); mxa = max3f(mxa, p[3][r], p[3][r + 1]); mxb = max3f(mxb, p[3][r + 2], p[3][r + 3]); }
            }
            float mx = max3f(mxa, mxb, m_run);
            mx = max3f(mx, __shfl_xor(mx, 32), mx);
            const float mnew = mx, alpha = fast_exp2(m_run - mnew);
            const bool grew = __builtin_amdgcn_ballot_w64(mnew > m_run) != 0ull;
            m_run = mnew;
            typedef float f32x2v __attribute__((ext_vector_type(2)));
            const f32x2v mm = {mnew, mnew}; f32x2v sum2 = {0.f, 0.f};
#pragma unroll
            for (int q = 0; q < NPB; ++q)
#pragma unroll
                for (int r = 0; r < 16; r += 2) {
                    f32x2v a = (f32x2v){p[q][r], p[q][r + 1]} - mm;
                    a.x = fast_exp2(a.x); a.y = fast_exp2(a.y);
                    p[q][r] = a.x; p[q][r + 1] = a.y; sum2 += a;
                }
            const float sum = sum2.x + sum2.y;
            l_run = l_run * alpha + sum;
            if (grew) {
#pragma unroll
                for (int db = 0; db < DV / 32; ++db) o[db] *= alpha;
            }
            __builtin_amdgcn_sched_barrier(0);
            bf16x8 pf[NST];
#pragma unroll
            for (int s = 0; s < NST; ++s) {
                const int q = s >> 1, h8 = (s & 1) * 8; u32x4 w;
                w.x = cvtpk_c(p[q][h8 + 0], p[q][h8 + 1]); w.y = cvtpk_c(p[q][h8 + 2], p[q][h8 + 3]); w.z = cvtpk_c(p[q][h8 + 4], p[q][h8 + 5]); w.w = cvtpk_c(p[q][h8 + 6], p[q][h8 + 7]);
                pf[s] = __builtin_bit_cast(bf16x8, w);
            }
#pragma unroll
            for (int db = 0; db < DV / 32; ++db)
#pragma unroll
                for (int s = 0; s < NST; ++s) {
                    const s16x4 lo = vtr(vb + (16 * s) * VP + db * 64), hh = vtr(vb + (16 * s + 8) * VP + db * 64);
                    const bf16x8 vf = (bf16x8){lo[0], lo[1], lo[2], lo[3], hh[0], hh[1], hh[2], hh[3]};
                    o[db] = __builtin_amdgcn_mfma_f32_32x32x16_bf16(vf, pf[s], o[db], 0, 0, 0);
                    if ((s & 3) == 3) __builtin_amdgcn_sched_barrier(0);
                }
        }
        ATT_STORE(cur ^ 1);
#ifdef PROBE_STAGE2
        ATT_LOAD((t + 1 < t1 ? t + 1 : t1 - 1)); asm volatile("" ::: "memory"); ATT_STORE(cur ^ 1);
#endif
        __syncthreads();
    }
#undef ATT_LOAD
#undef ATT_STORE
}

template <int NQF> __device__ __forceinline__ void load_q(bf16x8 (&qf)[NQF], const bf16_t* qrow, int hi) {
#pragma unroll
    for (int ks = 0; ks < NQF; ++ks) qf[ks] = *(const bf16x8*)(qrow + 16 * ks + 8 * hi);
}
template <int NDB> __device__ __forceinline__ void store_o(bf16_t* orow, const f32x16 (&o)[NDB], float inv, int hi, bool valid) {
    if (!valid) return;
#pragma unroll
    for (int db = 0; db < NDB; ++db)
#pragma unroll
        for (int g = 0; g < 4; ++g) {
            u32x2 w; w.x = cvt_pk_bf16(o[db][4 * g] * inv, o[db][4 * g + 1] * inv); w.y = cvt_pk_bf16(o[db][4 * g + 2] * inv, o[db][4 * g + 3] * inv);
            *(u32x2*)(orow + 32 * db + 8 * g + 4 * hi) = w;
        }
}

__device__ __forceinline__ int t5_bucket(int rel) {
    const int n = rel < 0 ? -rel : rel; int b;
    if (n < 8) b = n; else if (n < 12) b = 8; else if (n < 16) b = 9; else if (n < 23) b = 10; else if (n < 32) b = 11; else if (n < 46) b = 12; else if (n < 64) b = 13; else if (n < 91) b = 14; else b = 15;
    return b + (rel > 0 ? 16 : 0);
}

__device__ __forceinline__ void attn_a(LAS unsigned char* lds, const Params& P) {
    unsigned char* ws = P.ws; const int tid = opq_tid(), lane = tid & 63, w = tid >> 6, l31 = lane & 31, hi = lane >> 5;
    bf16_t* O = (bf16_t*)(ws + WS_O); const bf16_t* QA = (const bf16_t*)(ws + WS_QA);
    LAS float* tab = (LAS float*)(lds + ATT_TAB);
    for (int u0 = opq_bid(); u0 < 1024 + 256; u0 += gridDim.x) {
        if (u0 >= 1024 && (((u0 - 1024) >> 3) & 1) == 0) continue;
        const int u = u0 >= 1024 ? 1024 + (((u0 - 1024) >> 4) * 8 + ((u0 - 1024) & 7)) : u0;
        const bool sample = u >= 1024; int b, h, qb = 0;
        if (!sample) { const int r = u >> 8, c = u & 255, xc = c & 7, j = c >> 3; const int bh = xc * 16 + (j >> 1); qb = 2 * r + (j & 1); b = bh >> 3; h = bh & 7; }
        else { const int s = u - 1024; b = s >> 3; h = s & 7; }
        if (tid < 256) { int rel = tid - 63; rel = rel > 64 ? 64 : rel; tab[tid] = P.in[17][h * 129 + rel + 64] * LOG2E; }
        KVSrc S; int t0, t1, w0, w1, nkeys, qpos, qpos_w0, kpos0; long qrow; bool valid;
        if (!sample) {
            const size_t base = (size_t)b * SEQ * 512 + h * 64;
            S = KVSrc{(const bf16_t*)(ws + WS_KA) + base, 512, nullptr, 0, (const bf16_t*)(ws + WS_VA) + base, 512};
            const int c0 = qb * 4, cw = c0 + (w >> 1);
            t0 = c0 - 8 < 0 ? 0 : c0 - 8; t1 = c0 + 4; w0 = cw - 8 < 0 ? 0 : cw - 8; w1 = cw + 1; nkeys = SEQ;
            qpos_w0 = qb * 256 + (w >> 1) * 64; qpos = qb * 256 + w * 32 + l31; kpos0 = 0; qrow = (long)b * SEQ + qpos; valid = true;
        } else {
            const size_t base = (size_t)b * KA_ROWS * 512 + h * 64;
            S = KVSrc{(const bf16_t*)(ws + WS_KAS) + base, 512, nullptr, 0, (const bf16_t*)(ws + WS_VAS) + base, 512};
            t0 = 0; t1 = 9; w0 = 0; w1 = (w == 0) ? 9 : 0; nkeys = 512 + NEW;
            qpos_w0 = PAST; qpos = PAST + (l31 & 15); kpos0 = PAST - 512; qrow = (long)TP + b * NEW + (l31 & 15); valid = (w == 0) && l31 < 16;
        }
        bf16x8 qf[4]; load_q<4>(qf, QA + qrow * 512 + h * 64, hi);
        f32x16 o[2];
#pragma unroll
        for (int db = 0; db < 2; ++db)
#pragma unroll
            for (int r = 0; r < 16; ++r) o[db][r] = 0.f;
        float m_run = NEGBIG, l_run = 0.f;
        flash_pass<64, 64, true, 128>(lds, S, t0, t1, w0, w1, nkeys, qf, qpos, qpos_w0, kpos0, o, m_run, l_run);
        l_run += __shfl_xor(l_run, 32);
        store_o<2>(O + qrow * 1024 + h * 64, o, 1.0f / l_run, hi, valid);
    }
}

__device__ __forceinline__ float diff_lambda(const Params& P) {
    float d1 = 0.f, d2 = 0.f;
    for (int i = 0; i < 64; ++i) { d1 += P.in[18][i] * P.in[19][i]; d2 += P.in[20][i] * P.in[21][i]; }
    return expf(d1) - expf(d2) + 0.2f;
}
__device__ __forceinline__ void attn_b(LAS unsigned char* lds, const Params& P) {
    unsigned char* ws = P.ws; const int tid = opq_tid(), lane = tid & 63, w = tid >> 6, l31 = lane & 31, hi = lane >> 5;
    bf16_t* O = (bf16_t*)(ws + WS_O); bf16_t* OT1 = (bf16_t*)(ws + WS_OT1); const bf16_t* QB = (const bf16_t*)(ws + WS_QB);
    LAS float* tab = (LAS float*)(lds + ATT_TAB);
    for (int u0 = opq_bid(); u0 < 1024 + 256; u0 += gridDim.x) {
        if (u0 >= 1024 && (((u0 - 1024) >> 3) & 1) == 1) continue;
        const int u = u0 >= 1024 ? 1024 + (((u0 - 1024) >> 4) * 8 + ((u0 - 1024) & 7)) : u0;
        const bool sample = u >= 1024; int b, h, mp, qb = 0;
        if (!sample) { const int r = u >> 8, c = u & 255, xc = c & 7, j = c >> 3; const int bhm = (xc * 8 + (j >> 2)) * 2 + ((j >> 1) & 1), p2 = j & 1; qb = p2 == 0 ? (r == 0 ? 0 : r == 1 ? 7 : r == 2 ? 2 : 5) : (r == 0 ? 1 : r == 1 ? 6 : r == 2 ? 3 : 4); b = bhm >> 3; h = (bhm >> 1) & 3; mp = bhm & 1; }
        else { const int s = u - 1024; b = s >> 3; h = (s >> 1) & 3; mp = s & 1; }
        if (tid < 256) tab[tid] = P.in[8][t5_bucket(63 - tid) * 4 + h] * LOG2E;
        int t0, t1, w0, w1, nkeys, qpos, qpos_w0; long qrow; bool valid; size_t kbase; const bf16_t *kp, *vp;
        if (!sample) {
            kbase = (size_t)b * SEQ * 512 + h * 128; kp = (const bf16_t*)(ws + WS_KB); vp = (const bf16_t*)(ws + WS_VB);
            const int c0 = qb * 4, cw = c0 + (w >> 1);
            t0 = 0; t1 = c0 + 4; w0 = 0; w1 = cw + 1; nkeys = SEQ;
            qpos_w0 = qb * 256 + (w >> 1) * 64; qpos = qb * 256 + w * 32 + l31; qrow = (long)b * SEQ + qpos; valid = true;
        } else {
            kbase = (size_t)b * KB_ROWS * 512 + h * 128; kp = (const bf16_t*)(ws + WS_KBS); vp = (const bf16_t*)(ws + WS_VBS);
            t0 = 0; t1 = 17; w0 = 0; w1 = (w == 0) ? 17 : 0; nkeys = PAST + NEW;
            qpos_w0 = PAST; qpos = PAST + (l31 & 15); qrow = (long)TP + b * NEW + (l31 & 15); valid = (w == 0) && l31 < 16;
        }
        KVSrc S{kp + kbase + mp * 64, 512, nullptr, 0, vp + kbase, 512};
        bf16x8 qf[4]; load_q<4>(qf, QB + qrow * 512 + h * 128 + mp * 64, hi);
        f32x16 o[4];
#pragma unroll
        for (int db = 0; db < 4; ++db)
#pragma unroll
            for (int r = 0; r < 16; ++r) o[db][r] = 0.f;
        float m_run = NEGBIG, l_run = 0.f;
        flash_pass<64, 128, true, 64>(lds, S, t0, t1, w0, w1, nkeys, qf, qpos, qpos_w0, 0, o, m_run, l_run);
        l_run += __shfl_xor(l_run, 32);
        store_o<4>(mp == 0 ? O + qrow * 1024 + 512 + h * 128 : OT1 + qrow * 512 + h * 128, o, 1.0f / l_run, hi, valid);
    }
}
__device__ __forceinline__ void combine_b(const Params& P) {
    unsigned char* ws = P.ws; const int tid = opq_tid(), lane = tid & 63, gw = opq_bid() * 8 + (tid >> 6), nw = gridDim.x * 8;
    bf16_t* O = (bf16_t*)(ws + WS_O); const bf16_t* OT1 = (const bf16_t*)(ws + WS_OT1);
    const float lam = diff_lambda(P), lam_init = 0.2f;
    const int h = lane >> 4, e = (lane & 15) * 8;
    const f32x4 g0 = *(const f32x4*)(P.in[22] + e), g1 = *(const f32x4*)(P.in[22] + e + 4);
    for (int row = gw; row < MT; row += nw) {
        bf16_t* op = O + (size_t)row * 1024 + 512 + h * 128 + e;
        f32x4 a0, b0, a1, b1; unpack8(*(const u32x4*)op, a0, b0); unpack8(*(const u32x4*)(OT1 + (size_t)row * 512 + h * 128 + e), a1, b1);
        a0 -= a1 * lam; b0 -= b1 * lam;
        float ss = (a0[0] * a0[0] + a0[1] * a0[1]) + (a0[2] * a0[2] + a0[3] * a0[3]) + (b0[0] * b0[0] + b0[1] * b0[1]) + (b0[2] * b0[2] + b0[3] * b0[3]);
        ss += __shfl_xor(ss, 1); ss += __shfl_xor(ss, 2); ss += __shfl_xor(ss, 4); ss += __shfl_xor(ss, 8);
        const float rs = rsqrtf(ss * (1.0f / 128.0f) + EPS) * (1.0f - lam_init);
        *(u32x4*)op = pack8(a0 * rs * g0, b0 * rs * g1);
    }
}

__device__ __forceinline__ void attn_c(LAS unsigned char* lds, const Params& P) {
    unsigned char* ws = P.ws; const int tid = opq_tid(), lane = tid & 63, w = tid >> 6, l31 = lane & 31, hi = lane >> 5;
    bf16_t* O = (bf16_t*)(ws + WS_O); const bf16_t* QC = (const bf16_t*)(ws + WS_QC);
    const bf16_t* KVC = (const bf16_t*)(ws + WS_KVC); const bf16_t* KRB = (const bf16_t*)(ws + WS_KRB);
    for (int u = opq_bid(); u < 2048 + 256; u += gridDim.x) {
        const bool sample = u >= 2048; int b, h, qb = 0;
        if (!sample) { const int r = u >> 8, c = u & 255, xc = c & 7, j = c >> 3; const int bh = (r >> 1) * 64 + xc * 8 + (j >> 2), m4 = j & 3; qb = (r & 1) ? 7 - m4 : m4; b = bh >> 4; h = bh & 15; }
        else { const int s = u - 2048; b = s >> 4; h = s & 15; }
        int t0, t1, w0, w1, nkeys, qpos, qpos_w0; long qrow, krow0; bool valid;
        if (!sample) {
            krow0 = (long)b * SEQ; const int c0 = qb * 4, cw = c0 + (w >> 1);
            t0 = 0; t1 = c0 + 4; w0 = 0; w1 = cw + 1; nkeys = SEQ;
            qpos_w0 = qb * 256 + (w >> 1) * 64; qpos = qb * 256 + w * 32 + l31; qrow = (long)b * SEQ + qpos; valid = true;
        } else {
            krow0 = (long)TP + (long)b * (PAST + NEW);
            t0 = 0; t1 = 17; w0 = 0; w1 = (w == 0) ? 17 : 0; nkeys = PAST + NEW;
            qpos_w0 = PAST; qpos = PAST + (l31 & 15); qrow = (long)TP + b * NEW + (l31 & 15); valid = (w == 0) && l31 < 16;
        }
        const bf16_t* kvh = sample ? KVC + KVC_S_OFF + ((size_t)(b * 16 + h) * KC_ROWS) * 128 : KVC + ((size_t)(b * 16 + h) * SEQ) * 128;
        KVSrc S{kvh, 128, KRB + krow0 * 32, 32, kvh + 64, 128};
        bf16x8 qf[6]; load_q<6>(qf, QC + qrow * 1536 + h * 96, hi);
        f32x16 o[2];
#pragma unroll
        for (int db = 0; db < 2; ++db)
#pragma unroll
            for (int r = 0; r < 16; ++r) o[db][r] = 0.f;
        float m_run = NEGBIG, l_run = 0.f;
        flash_pass<96, 64, false, 128>(lds, S, t0, t1, w0, w1, nkeys, qf, qpos, qpos_w0, 0, o, m_run, l_run);
        l_run += __shfl_xor(l_run, 32);
        store_o<2>(O + qrow * 1024 + h * 64, o, 1.0f / l_run, hi, valid);
    }
}

#define XB_TMO      128
#define XB_XCNT(j)  (256  + 64 * (j))
#define XB_XSUB(j)  (1280 + 64 * (j))
#define XB_XGEN(j)  (2304 + 64 * (j))
#define XB_TOP      3328
#define XB_TOPGEN   3392
#define XCD_BAR_WORDS 3456
#define XB_SPIN_CAP (1u << 18)

__device__ __forceinline__ unsigned xb_ld(unsigned* p)              { return __hip_atomic_load(p, __ATOMIC_RELAXED, __HIP_MEMORY_SCOPE_AGENT); }
__device__ __forceinline__ unsigned xb_add(unsigned* p, unsigned v) { return __hip_atomic_fetch_add(p, v, __ATOMIC_RELAXED, __HIP_MEMORY_SCOPE_AGENT); }
__device__ __forceinline__ unsigned xb_xcc_id() { return (unsigned)__builtin_amdgcn_s_getreg((3 << 11) | 20) & 0xFu; }
#define XB_SPIN(cond, bar) do { unsigned _sp = 0; while (cond) { __builtin_amdgcn_s_sleep(1); \
    if ((++_sp & 255u) == 0u) { if (xb_ld(&(bar)[XB_TMO])) break; if (_sp > XB_SPIN_CAP) { atomicAdd(&(bar)[XB_TMO], 1u); break; } } } } while (0)

struct XcdBarrier {
    unsigned* bar; unsigned x;
    volatile LAS unsigned* st;
};

__device__ __forceinline__ XcdBarrier xcd_barrier_post(unsigned* bar, volatile LAS unsigned* st) {
    XcdBarrier b; b.bar = bar; b.x = xb_xcc_id(); b.st = st;
    if (threadIdx.x == 0) (void)xb_add(&bar[XB_XCNT(b.x)], 1u);
    return b;
}
__device__ __forceinline__ void xcd_barrier_complete(unsigned* bar, unsigned x, unsigned& nloc, unsigned& nx) {
    const unsigned G = gridDim.x * gridDim.y * gridDim.z;
    unsigned sum, cnt, mine, sp = 0u;
    for (;;) {
        sum = 0u; cnt = 0u; mine = 0u;
#pragma unroll
        for (unsigned j = 0; j < 16; ++j) { const unsigned c = xb_ld(&bar[XB_XCNT(j)]); sum += c; cnt += (c > 0u) ? 1u : 0u; mine = (j == x) ? c : mine; }
        if (sum == G) break;
        __builtin_amdgcn_s_sleep(1);
        if ((++sp & 255u) == 0u) { if (xb_ld(&bar[XB_TMO])) break; if (sp > XB_SPIN_CAP) { atomicAdd(&bar[XB_TMO], 1u); break; } }
    }
    nloc = mine > 0u ? mine : 1u; nx = cnt > 0u ? cnt : 1u;
}

__device__ __forceinline__ void xcd_barrier(const XcdBarrier& b) {
    asm volatile("s_waitcnt vmcnt(0)" ::: "memory");
    __syncthreads();
    if (threadIdx.x == 0) {
        unsigned* bar = b.bar;
        __builtin_amdgcn_s_waitcnt(0);
        unsigned nloc = b.st[0], nx = b.st[1];
        if (nloc == 0u) { xcd_barrier_complete(bar, b.x, nloc, nx); b.st[0] = nloc; b.st[1] = nx; }
        const unsigned old = xb_add(&bar[XB_XSUB(b.x)], 1u);
        const unsigned gen = old / nloc;
        if (old + 1u == (gen + 1u) * nloc) {
            __builtin_amdgcn_fence(__ATOMIC_RELEASE, "agent");
            asm volatile("s_waitcnt vmcnt(0)" ::: "memory");
            const unsigned og = xb_add(&bar[XB_TOP], 1u);
            const unsigned tg = og / nx;
            if (og + 1u == (tg + 1u) * nx) xb_add(&bar[XB_TOPGEN], 1u);
            else XB_SPIN(xb_ld(&bar[XB_TOPGEN]) == tg, bar);
            __builtin_amdgcn_fence(__ATOMIC_ACQUIRE, "agent");
            xb_add(&bar[XB_XGEN(b.x)], 1u);
            asm volatile("s_waitcnt vmcnt(0)" ::: "memory");
        } else {
            XB_SPIN(xb_ld(&bar[XB_XGEN(b.x)]) == gen, bar);
            __builtin_amdgcn_fence(__ATOMIC_ACQUIRE, "agent");
            asm volatile("s_waitcnt vmcnt(0)" ::: "memory");
        }
    }
    __syncthreads();
}


constexpr int N_PHASES = 18;
__global__ void __launch_bounds__(512, 2) fwd_megakernel(Params P) {
    extern __shared__ __attribute__((aligned(16))) unsigned char lds_raw[];
    LAS unsigned char* lds = (LAS unsigned char*)lds_raw;
    cg::grid_group grid = cg::this_grid();
    unsigned char* ws = P.ws; float* x = P.out;
    bf16_t* xb = (bf16_t*)(ws + WS_XB); float* ssp = (float*)(ws + WS_SSP); float* ssps = (float*)(ws + WS_SSPS); bf16_t* act = (bf16_t*)(ws + WS_ACT); bf16_t* O = (bf16_t*)(ws + WS_O);
    const int lo = P.ph_lo, hi = P.ph_hi;
    volatile LAS unsigned* bst = (volatile LAS unsigned*)(lds + 131072);
    if (threadIdx.x < 2) bst[threadIdx.x] = 0u;
    __syncthreads();
    XcdBarrier bar = xcd_barrier_post((unsigned*)(ws + WS_CTL), bst);
#define PH(k) if (lo <= (k) && (k) < hi)
#define SEAM(k) if (lo <= (k) && (k) + 1 < hi) { if ((k) == 0) grid.sync(); else xcd_barrier(bar); }
    PH(0) { prologue(lds, P);
#ifdef PROBE_PRO2
        prologue(lds, P);
#endif
    } SEAM(0)
#define WGU(i) ((const bf16_t*)(ws + W_GU + (size_t)(i) * W_GU_SZ))
#define WDN(i) ((const bf16_t*)(ws + W_DN + (size_t)(i) * W_DN_SZ))
    PH(1) { skinny_gemm<4, 4>(xb + (size_t)TP * D, WGU(0), D, FF / 32, SkSwiglu4{act, ssps}); run_gemm(lds, xb, WGU(0), TP, 2 * FF, D, EpiSwiglu{act, ssp});
#ifdef PROBE_UP2
        skinny_gemm<4, 4>(xb + (size_t)TP * D, WGU(0), D, FF / 32, SkSwiglu4{act, ssps}); run_gemm(lds, xb, WGU(0), TP, 2 * FF, D, EpiSwiglu{act, ssp});
#endif
    } SEAM(1)
    PH(2) {
#ifdef PROBE_DN2
        skinny_gemm<1, 11>(act + (size_t)TP * FF, WDN(0), FF, D / 16, SkResid{x, xb, ssps, 0.25f}); run_gemm(lds, act, WDN(0), TP, D, FF, EpiResid{x, xb, ssp, 0.25f});
        skinny_gemm<1, 11>(act + (size_t)TP * FF, WDN(0), FF, D / 16, SkResid{x, xb, ssps, 0.25f}); run_gemm(lds, act, WDN(0), TP, D, FF, EpiResid{x, xb, ssp, 0.25f});
#else
        skinny_gemm<1, 11, SkResid, 4>(act + (size_t)TP * FF, WDN(0), FF, D / 16, SkResid{x, xb, ssps, 0.5f}, 0, lds); run_gemm(lds, act, WDN(0), TP, D, FF, EpiResid{x, xb, ssp, 0.5f});
#endif
 } SEAM(2)
    PH(3) { skinny_gemm<1, 8>(xb + (size_t)TP * D, (const bf16_t*)(ws + W_IN0), D, 192, SkIn0{ssps, ws, P.out}); run_gemm(lds, xb, (const bf16_t*)(ws + W_IN0), TP, 3072, D, EpiIn0{ssp, ws, P.out}); } SEAM(3)
    PH(4) {
#ifndef DIS_A
        attn_a(lds, P);
#endif
#ifndef DIS_B
        attn_b(lds, P);
#endif
#ifdef PROBE_ATT2
        attn_a(lds, P); attn_b(lds, P);
#endif
        if (hi > 5) { xcd_barrier(bar); combine_b(P); }
    } SEAM(4)
    PH(5) { skinny_gemm<1, 4, SkResid, 4>(O + (size_t)TP * D, (const bf16_t*)(ws + W_OUT0), D, D / 16, SkResid{x, xb, ssps, 1.0f}, 0, lds); run_gemm(lds, O, (const bf16_t*)(ws + W_OUT0), TP, D, D, EpiResid{x, xb, ssp, 1.0f}); } SEAM(5)
    PH(6) { skinny_gemm<4, 4>(xb + (size_t)TP * D, WGU(1), D, FF / 32, SkSwiglu4{act, ssps}); run_gemm(lds, xb, WGU(1), TP, 2 * FF, D, EpiSwiglu{act, ssp});
#ifdef PROBE_UP2
        skinny_gemm<4, 4>(xb + (size_t)TP * D, WGU(1), D, FF / 32, SkSwiglu4{act, ssps}); run_gemm(lds, xb, WGU(1), TP, 2 * FF, D, EpiSwiglu{act, ssp});
#endif
    } SEAM(6)
    PH(7) {
#ifdef PROBE_DN2
        skinny_gemm<1, 11>(act + (size_t)TP * FF, WDN(1), FF, D / 16, SkResid{x, xb, ssps, 0.25f}); run_gemm(lds, act, WDN(1), TP, D, FF, EpiResid{x, xb, ssp, 0.25f});
        skinny_gemm<1, 11>(act + (size_t)TP * FF, WDN(1), FF, D / 16, SkResid{x, xb, ssps, 0.25f}); run_gemm(lds, act, WDN(1), TP, D, FF, EpiResid{x, xb, ssp, 0.25f});
#else
        skinny_gemm<1, 11, SkResid, 4>(act + (size_t)TP * FF, WDN(1), FF, D / 16, SkResid{x, xb, ssps, 0.5f}, 0, lds); run_gemm(lds, act, WDN(1), TP, D, FF, EpiResid{x, xb, ssp, 0.5f});
#endif
 } SEAM(7)
    PH(8) { skinny_gemm<4, 4>(xb + (size_t)TP * D, WGU(2), D, FF / 32, SkSwiglu4{act, ssps}); run_gemm(lds, xb, WGU(2), TP, 2 * FF, D, EpiSwiglu{act, ssp});
#ifdef PROBE_UP2
        skinny_gemm<4, 4>(xb + (size_t)TP * D, WGU(2), D, FF / 32, SkSwiglu4{act, ssps}); run_gemm(lds, xb, WGU(2), TP, 2 * FF, D, EpiSwiglu{act, ssp});
#endif
    } SEAM(8)
    PH(9) {
#ifdef PROBE_DN2
        skinny_gemm<1, 11>(act + (size_t)TP * FF, WDN(2), FF, D / 16, SkResid{x, xb, ssps, 0.25f}); run_gemm(lds, act, WDN(2), TP, D, FF, EpiResid{x, xb, ssp, 0.25f});
        skinny_gemm<1, 11>(act + (size_t)TP * FF, WDN(2), FF, D / 16, SkResid{x, xb, ssps, 0.25f}); run_gemm(lds, act, WDN(2), TP, D, FF, EpiResid{x, xb, ssp, 0.25f});
#else
        skinny_gemm<1, 11, SkResid, 4>(act + (size_t)TP * FF, WDN(2), FF, D / 16, SkResid{x, xb, ssps, 0.5f}, 0, lds); run_gemm(lds, act, WDN(2), TP, D, FF, EpiResid{x, xb, ssp, 0.5f});
#endif
 } SEAM(9)
    PH(10) {
        const int G = (int)gridDim.x, half = G / 2;
        if ((int)blockIdx.x >= half) prologue_l1(P, (int)blockIdx.x - half, G - half);
        skinny_gemm<1, 8>(xb + (size_t)TP * D, (const bf16_t*)(ws + W_IN1), D, 42, SkIn1{ssps, ws, P.out}, half); run_gemm(lds, xb, (const bf16_t*)(ws + W_IN1), TP, 768, D, EpiIn1{ssp, ws, P.out}); } SEAM(10)
    PH(11) { thin_l1(P); skinny_gemm<1, 6>((const bf16_t*)(ws + WS_CQ) + (size_t)TP * 384, (const bf16_t*)(ws + W_QUP), 384, 96, SkQup{ws}); run_gemm(lds, (const bf16_t*)(ws + WS_CQ), (const bf16_t*)(ws + W_QUP), TP, 1536, 384, EpiQup{ws}); } SEAM(11)
    PH(12) { skinny_gemm<1, 4>((const bf16_t*)(ws + WS_CKVN) + (size_t)(MKV - 256) * 256, (const bf16_t*)(ws + W_KVUP), 256, 128, SkKvHead{(bf16_t*)(ws + WS_KVC)});
        run_gemm(lds, (const bf16_t*)(ws + WS_CKVN), (const bf16_t*)(ws + W_KVUP), MKV - 256, 2048, 256, EpiKvHead{(bf16_t*)(ws + WS_KVC)}); } SEAM(12)
    PH(13) {
#ifndef DIS_C
        attn_c(lds, P);
#endif
#ifdef PROBE_ATTC2
        attn_c(lds, P);
#endif
    } SEAM(13)
    PH(14) { skinny_gemm<1, 4, SkResid, 4>(O + (size_t)TP * D, (const bf16_t*)(ws + W_OUT1), D, D / 16, SkResid{x, xb, ssps, 1.0f}, 0, lds); run_gemm(lds, O, (const bf16_t*)(ws + W_OUT1), TP, D, D, EpiResid{x, xb, ssp, 1.0f}); } SEAM(14)
    PH(15) { skinny_gemm<4, 4>(xb + (size_t)TP * D, WGU(3), D, FF / 32, SkSwiglu4{act, ssps}); run_gemm(lds, xb, WGU(3), TP, 2 * FF, D, EpiSwiglu{act, ssp});
#ifdef PROBE_UP2
        skinny_gemm<4, 4>(xb + (size_t)TP * D, WGU(3), D, FF / 32, SkSwiglu4{act, ssps}); run_gemm(lds, xb, WGU(3), TP, 2 * FF, D, EpiSwiglu{act, ssp});
#endif
    } SEAM(15)
    PH(16) {
#ifdef PROBE_DN2
        skinny_gemm<1, 11>(act + (size_t)TP * FF, WDN(3), FF, D / 16, SkResid{x, xb, ssps, 0.25f}); run_gemm(lds, act, WDN(3), TP, D, FF, EpiResid{x, xb, ssp, 0.25f});
        skinny_gemm<1, 11>(act + (size_t)TP * FF, WDN(3), FF, D / 16, SkResid{x, xb, ssps, 0.25f}); run_gemm(lds, act, WDN(3), TP, D, FF, EpiResid{x, xb, ssp, 0.25f});
#else
        skinny_gemm<1, 11, SkResid, 4>(act + (size_t)TP * FF, WDN(3), FF, D / 16, SkResid{x, xb, ssps, 0.5f}, 0, lds); run_gemm(lds, act, WDN(3), TP, D, FF, EpiResid{x, xb, ssp, 0.5f});
#endif
 } SEAM(16)
    const int ph = 17;
    PH(ph) { final_norm(P); }
#undef PH
#undef SEAM
}

#ifndef MK_SPLIT
#define MK_SPLIT 0
#endif
extern "C" void kernel_launch(void* const* d_in, const int* in_sizes, int n_in, void* d_out, int out_size, void* d_ws, size_t ws_size, hipStream_t stream) {
    static int grid_blocks = 0;
    if (grid_blocks == 0) {
        if (n_in != 31 || (size_t)out_size != O_END || ws_size < WS_CTL + CTL_BYTES) { fprintf(stderr, "kernel_launch: unexpected sizes n_in %d out %d ws %zu (need %zu)\n", n_in, out_size, ws_size, (size_t)WS_END); grid_blocks = -1; return; }
        int dev = 0, cus = 0, per_cu = 0;
        hipGetDevice(&dev); hipDeviceGetAttribute(&cus, hipDeviceAttributeMultiprocessorCount, dev);
        if (hipFuncSetAttribute((const void*)fwd_megakernel, hipFuncAttributeMaxDynamicSharedMemorySize, LDS_BYTES) != hipSuccess) { fprintf(stderr, "kernel_launch: hipFuncSetAttribute failed\n"); grid_blocks = -1; return; }
        if (hipOccupancyMaxActiveBlocksPerMultiprocessor(&per_cu, (const void*)fwd_megakernel, 512, LDS_BYTES) != hipSuccess || per_cu < 1) { fprintf(stderr, "kernel_launch: occupancy query says %d\n", per_cu); per_cu = 1; }
        (void)hipGetLastError();
        grid_blocks = cus * per_cu;
        fprintf(stderr, "kernel_launch: grid %d (cus %d x %d)\n", grid_blocks, cus, per_cu);
    }
    if (grid_blocks < 0) return;
    if (hipMemsetAsync((char*)d_ws + WS_CTL, 0, CTL_BYTES, stream) != hipSuccess) { fprintf(stderr, "kernel_launch: memset failed\n"); return; }
    Params p{};
    for (int i = 0; i < 31; ++i) p.in[i] = (const float*)d_in[i];
    p.out = (float*)d_out; p.ws = (unsigned char*)d_ws;
#if MK_SPLIT
    for (int k = 0; k < N_PHASES; ++k) { p.ph_lo = k; p.ph_hi = k + 1; hipLaunchKernelGGL(fwd_megakernel, dim3(grid_blocks), dim3(512), LDS_BYTES, stream, p); }
#else
    p.ph_lo = 0; p.ph_hi = N_PHASES;
    void* args[] = {&p};
    hipError_t e = hipLaunchCooperativeKernel((const void*)fwd_megakernel, dim3(grid_blocks), dim3(512), args, LDS_BYTES, stream);
    if (e != hipSuccess) fprintf(stderr, "kernel_launch: cooperative launch failed: %s (grid %d)\n", hipGetErrorString(e), grid_blocks);
#endif
}
```

```cpp
#include <hip/hip_runtime.h>
#include <cstdio>
#include <cstdint>
namespace pg8 {
#define PG8_LAS __attribute__((address_space(3)))
typedef unsigned short bf16_t;
typedef short bf16x8 __attribute__((ext_vector_type(8)));
typedef float f32x4 __attribute__((ext_vector_type(4)));
typedef unsigned u32x4 __attribute__((ext_vector_type(4)));
constexpr int BM = 256, BK = 64, HALF = 128, HTB = HALF * BK * 2  , STAGE_BYTES = 8 * HTB, NXCD = 8, WGM = 8;

__host__ __device__ __forceinline__ int lds_byte(int r, int c) { const int st = (r >> 4) * 2 + (c >> 5), rr = r & 15, cc = c & 31, ob = rr * 64 + cc * 2; return st * 1024 + (ob ^ (((ob >> 9) & 1) << 5)); }
__host__ __device__ __forceinline__ void stage_rc(int b, int& R, int& C) { const int st = b / 1024, sb = b % 1024, swz = sb ^ (((sb >> 9) & 1) << 5); R = (st >> 1) * 16 + swz / 64; C = (st & 1) * 32 + (swz % 64) / 2; }
__host__ __device__ __forceinline__ int perm32(int rho) { const int n = rho >> 4, i = rho & 15; return 8 * (i >> 2) + 4 * n + (i & 3); }

struct Unit { int pm, pn; };
struct Gemm { const bf16_t* A; const bf16_t* Bt; int M, N, K; };

struct StaticOrder {
    int nM, nN, nwg, G, c;
    __host__ __device__ void init(int M, int N, int G_, int c_) { nM = M / BM; nN = N / BM; nwg = nM * nN; G = G_; c = c_; }
    __host__ __device__ bool next(int i, Unit& u) const {
        const long L = (long)i * G + c; if (L >= nwg) return false;
        int wgid = (int)L; { const int q = nwg / NXCD, r = nwg % NXCD, xcd = wgid % NXCD, off = wgid / NXCD; wgid = (xcd < r ? xcd * (q + 1) : r * (q + 1) + (xcd - r) * q) + off; }
        const int nig = WGM * nN, gid = wgid / nig, fm = gid * WGM, gsz = (nM - fm) < WGM ? (nM - fm) : WGM;
        u.pm = fm + ((wgid % nig) % gsz); u.pn = (wgid % nig) / gsz; return true;
    }
    __device__ __forceinline__ void a_ready(const Unit&) const {}
    __device__ __forceinline__ void done(const Unit&) const {}
};
__device__ __forceinline__ unsigned cvt_pk_bf16(float lo, float hi) { unsigned r; asm volatile("v_cvt_pk_bf16_f32 %0, %1, %2" : "=v"(r) : "v"(lo), "v"(hi)); return r; }
template <class Epi, class Sched, bool ALIGN_EPI = false, bool SP2 = false>
__device__ __forceinline__ void gemm_phase(PG8_LAS unsigned char* lds, const Gemm g, const Sched& S, const Epi& E) {
    const int tid = threadIdx.x, wid = __builtin_amdgcn_readfirstlane(tid >> 6), lane = tid & 63, wr = wid >> 2, wc = wid & 3, fr = lane & 15, fq = lane >> 4;
    const int K = g.K, nt = K / BK;
    unsigned voffA[2], voffB[2];
#pragma unroll
    for (int i = 0; i < 2; ++i) { int R, C; stage_rc(tid * 16 + i * 8192, R, C); const int Rb = Epi::PERM ? ((R & ~31) + perm32(R & 31)) : R;
        voffA[i] = (unsigned)(R * K + C) * 2u; voffB[i] = (unsigned)(Rb * K + C) * 2u; }
    const size_t kstep = (size_t)(BK * 2);
    const size_t hstep = (size_t)HALF * K * 2;
    const size_t tstep = 2 * hstep;
    const unsigned ldsw = (unsigned)wid * 1024u;
    const int aoff = lds_byte(wr * 64 + fr, fq * 8), boff = lds_byte(wc * 32 + fr, fq * 8);
#define PG8_SA(b, h) (((b) * 2 + (h)) * HTB)
#define PG8_SB(b, h) ((4 + (b) * 2 + (h)) * HTB)
#define PG8_STAGE(bufoff, gbase, voff) do { _Pragma("unroll") for (int _i = 0; _i < 2; ++_i) \
        __builtin_amdgcn_global_load_lds((const unsigned*)((const char*)(gbase) + (voff)[_i]), (PG8_LAS unsigned*)(lds + (bufoff) + ldsw + _i * 8192), 16, 0, 0); } while (0)
#define PG8_LDA(dst, b, h) do { _Pragma("unroll") for (int m = 0; m < 4; ++m) _Pragma("unroll") for (int k = 0; k < 2; ++k) dst[m][k] = *(const PG8_LAS bf16x8*)(lds + PG8_SA(b, h) + aoff + m * 2048 + k * 1024); } while (0)
#define PG8_LDB(dst, b, h) do { _Pragma("unroll") for (int n = 0; n < 2; ++n) _Pragma("unroll") for (int k = 0; k < 2; ++k) dst[n][k] = *(const PG8_LAS bf16x8*)(lds + PG8_SB(b, h) + boff + n * 2048 + k * 1024); } while (0)
#define PG8_MMA(ai, bj, At, Bt) do { __builtin_amdgcn_s_setprio(1); _Pragma("unroll") for (int m = 0; m < 4; ++m) _Pragma("unroll") for (int n = 0; n < 2; ++n) _Pragma("unroll") for (int k = 0; k < 2; ++k) \
        acc[ai][bj][m][n] = __builtin_amdgcn_mfma_f32_16x16x32_bf16(Bt[n][k], At[m][k], acc[ai][bj][m][n], 0, 0, 0); __builtin_amdgcn_s_setprio(0); } while (0)
#define PG8_WAIT_V(n) asm volatile("s_waitcnt vmcnt(" #n ")" ::: "memory")
#define PG8_WAIT_L(n) asm volatile("s_waitcnt lgkmcnt(" #n ")" ::: "memory")
#define PG8_BAR __builtin_amdgcn_s_barrier()
#define PG8_SCHED __builtin_amdgcn_sched_barrier(0)
    Unit cur, nxt; int ui = 0;
    if (!S.next(0, cur)) return;
    f32x4 acc[2][2][4][2];
#pragma unroll
    for (int a = 0; a < 2; ++a)
#pragma unroll
        for (int b = 0; b < 2; ++b)
#pragma unroll
            for (int m = 0; m < 4; ++m)
#pragma unroll
                for (int n = 0; n < 2; ++n) acc[a][b][m][n] = (f32x4){0.f, 0.f, 0.f, 0.f};
    bf16x8 At[4][2], B0[2][2], B1[2][2];
    const char* cA = (const char*)g.A + (size_t)cur.pm * tstep; const char* cB = (const char*)g.Bt + (size_t)cur.pn * tstep;
    S.a_ready(cur);
    if constexpr (SP2) {
        PG8_STAGE(PG8_SB(0, 0), cB, voffB); PG8_STAGE(PG8_SB(0, 1), cB + hstep, voffB); PG8_STAGE(PG8_SA(0, 0), cA, voffA); PG8_STAGE(PG8_SA(0, 1), cA + hstep, voffA);
        if (wr == 1) PG8_BAR;
        PG8_WAIT_V(2); PG8_BAR;
        PG8_STAGE(PG8_SB(1, 0), cB + kstep, voffB); PG8_STAGE(PG8_SA(1, 0), cA + kstep, voffA); PG8_STAGE(PG8_SB(1, 1), cB + hstep + kstep, voffB);
        PG8_WAIT_V(6); PG8_BAR;
    } else {
        PG8_STAGE(PG8_SB(0, 0), cB, voffB); PG8_STAGE(PG8_SA(0, 0), cA, voffA); PG8_STAGE(PG8_SB(0, 1), cB + hstep, voffB); PG8_STAGE(PG8_SA(0, 1), cA + hstep, voffA);
        if (wr == 1) PG8_BAR;
        PG8_WAIT_V(4); PG8_BAR;
        PG8_STAGE(PG8_SB(1, 0), cB + kstep, voffB); PG8_STAGE(PG8_SA(1, 0), cA + kstep, voffA); PG8_STAGE(PG8_SB(1, 1), cB + hstep + kstep, voffB);
        PG8_WAIT_V(6); PG8_BAR;
    }
    for (;;) {
        const bool has_next = S.next(ui + 1, nxt);
        const char* nA = has_next ? (const char*)g.A + (size_t)nxt.pm * tstep : cA; const char* nB = has_next ? (const char*)g.Bt + (size_t)nxt.pn * tstep : cB;
        for (int t = 0; t < nt; t += 2) {
            const bool last = (t == nt - 2);
            const char* a1 = cA + (size_t)(t + 1) * kstep;
            const char* a2 = last ? nA : cA + (size_t)(t + 2) * kstep; const char* b2 = last ? nB : cB + (size_t)(t + 2) * kstep;
            const char* a3 = a2 + kstep; const char* b3 = b2 + kstep;
            if (last && has_next) S.a_ready(nxt);
            if constexpr (SP2) {
            PG8_LDB(B0, 0, 0); PG8_LDB(B1, 0, 1); PG8_SCHED; PG8_LDA(At, 0, 0); PG8_STAGE(PG8_SA(1, 1), a1 + hstep, voffA);
            PG8_WAIT_V(8); PG8_WAIT_L(0); PG8_BAR; PG8_MMA(0, 0, At, B0); PG8_MMA(0, 1, At, B1); PG8_BAR; PG8_SCHED;
            PG8_LDA(At, 0, 1); PG8_STAGE(PG8_SB(0, 0), b2, voffB); PG8_STAGE(PG8_SB(0, 1), b2 + hstep, voffB); PG8_STAGE(PG8_SA(0, 0), a2, voffA);
            PG8_WAIT_V(8); PG8_WAIT_L(0); PG8_BAR; PG8_MMA(1, 0, At, B0); PG8_MMA(1, 1, At, B1); PG8_BAR; PG8_SCHED;
            PG8_LDB(B0, 1, 0); PG8_LDB(B1, 1, 1); PG8_SCHED; PG8_LDA(At, 1, 0); PG8_STAGE(PG8_SA(0, 1), a2 + hstep, voffA);
            PG8_WAIT_V(8); PG8_WAIT_L(0); PG8_BAR; PG8_MMA(0, 0, At, B0); PG8_MMA(0, 1, At, B1); PG8_BAR; PG8_SCHED;
            PG8_LDA(At, 1, 1); PG8_STAGE(PG8_SB(1, 0), b3, voffB); PG8_STAGE(PG8_SB(1, 1), b3 + hstep, voffB); PG8_STAGE(PG8_SA(1, 0), a3, voffA);
            PG8_WAIT_V(8); PG8_WAIT_L(0); PG8_BAR; PG8_MMA(1, 0, At, B0); PG8_MMA(1, 1, At, B1); PG8_BAR; PG8_SCHED;
            } else {
            PG8_LDB(B0, 0, 0); PG8_SCHED; PG8_LDA(At, 0, 0); PG8_STAGE(PG8_SA(1, 1), a1 + hstep, voffA);
            PG8_WAIT_L(8); PG8_BAR; PG8_WAIT_L(0); PG8_MMA(0, 0, At, B0); PG8_BAR; PG8_SCHED;
            PG8_LDB(B1, 0, 1); PG8_STAGE(PG8_SB(0, 0), b2, voffB);
            PG8_BAR; PG8_WAIT_L(0); PG8_MMA(0, 1, At, B1); PG8_BAR;
            PG8_LDA(At, 0, 1); PG8_STAGE(PG8_SA(0, 0), a2, voffA);
            PG8_BAR; PG8_WAIT_L(0); PG8_MMA(1, 0, At, B0); PG8_BAR; PG8_SCHED;
            PG8_STAGE(PG8_SB(0, 1), b2 + hstep, voffB);
            PG8_WAIT_V(6); PG8_BAR; PG8_MMA(1, 1, At, B1); PG8_BAR;
            PG8_LDB(B0, 1, 0); PG8_SCHED; PG8_LDA(At, 1, 0); PG8_STAGE(PG8_SA(0, 1), a2 + hstep, voffA);
            PG8_WAIT_L(8); PG8_BAR; PG8_WAIT_L(0); PG8_MMA(0, 0, At, B0); PG8_BAR; PG8_SCHED;
            PG8_LDB(B1, 1, 1); PG8_STAGE(PG8_SB(1, 0), b3, voffB);
            PG8_BAR; PG8_WAIT_L(0); PG8_MMA(0, 1, At, B1); PG8_BAR;
            PG8_LDA(At, 1, 1); PG8_STAGE(PG8_SA(1, 0), a3, voffA);
            PG8_BAR; PG8_WAIT_L(0); PG8_MMA(1, 0, At, B0); PG8_BAR; PG8_SCHED;
            PG8_STAGE(PG8_SB(1, 1), b3 + hstep, voffB);
            PG8_WAIT_V(6); PG8_BAR; PG8_MMA(1, 1, At, B1); PG8_BAR;
            }
        }
        if constexpr (ALIGN_EPI) { if (wr == 0) PG8_BAR; }
        if constexpr (!Epi::AFTER_DRAIN) { E(acc, cur, wr, wc, fr, fq); S.done(cur); }
        if (!has_next) break;
#pragma unroll
        for (int a = 0; a < 2; ++a)
#pragma unroll
            for (int b = 0; b < 2; ++b)
#pragma unroll
                for (int m = 0; m < 4; ++m)
#pragma unroll
                    for (int n = 0; n < 2; ++n) acc[a][b][m][n] = (f32x4){0.f, 0.f, 0.f, 0.f};
        cur = nxt; cA = nA; cB = nB; ++ui;
        if constexpr (ALIGN_EPI) { if (wr == 1) PG8_BAR; }
    }
    PG8_WAIT_V(0);
    if constexpr (!ALIGN_EPI) { if (wr == 0) PG8_BAR; }
    PG8_BAR;
    if constexpr (Epi::AFTER_DRAIN) { E.fused(acc, cur, wr, wc, fr, fq, lds, wid, lane); S.done(cur); }
#undef PG8_SA
#undef PG8_SB
#undef PG8_STAGE
#undef PG8_LDA
#undef PG8_LDB
#undef PG8_MMA
#undef PG8_WAIT_V
#undef PG8_WAIT_L
#undef PG8_BAR
#undef PG8_SCHED
}
}

#include <hip/hip_cooperative_groups.h>
namespace cg = cooperative_groups;
#define LAS __attribute__((address_space(3)))
typedef unsigned short bf16_t;
typedef short bf16x8 __attribute__((ext_vector_type(8)));
typedef short s16x4 __attribute__((ext_vector_type(4)));
typedef float f32x4 __attribute__((ext_vector_type(4)));
typedef float f32x16 __attribute__((ext_vector_type(16)));
typedef unsigned u32x4 __attribute__((ext_vector_type(4)));
typedef unsigned u32x2 __attribute__((ext_vector_type(2)));
using pg8::cvt_pk_bf16;

constexpr int TP = 32768, TS = 256, MT = TP + TS;
constexpr int D = 1024, FF = 2816, SEQ = 2048, NB = 16, NEW = 16, PAST = 1024;
constexpr int SROWS_C = NB * (PAST + NEW);
constexpr int MKV = TP + SROWS_C;
constexpr int KA_ROWS = 576, KB_ROWS = 1088;
constexpr float EPS = 1e-6f, LOG2E = 1.4426950408889634f;
constexpr float QS_AB = 0.125f * LOG2E;
constexpr float QS_C = 0.10206207261596575f * LOG2E;
constexpr float NEGBIG = -1e30f;

constexpr size_t O_Y = 0, O_PAK = (size_t)MT * D, O_PAV = O_PAK + 4194304, O_PBK = O_PAV + 4194304, O_PBV = O_PBK + 16777216,
                 O_PCKV = O_PBV + 16777216, O_PCKR = O_PCKV + 8388608, O_SAK = O_PCKR + 1048576, O_SAV = O_SAK + 131072,
                 O_SBK = O_SAV + 131072, O_SBV = O_SBK + 131072, O_SCKV = O_SBV + 131072, O_SCKR = O_SCKV + 65536, O_END = O_SCKR + 8192;
static_assert(O_END == 85794816, "d_out map");

constexpr size_t al256(size_t x) { return (x + 255) & ~(size_t)255; }
constexpr size_t W_GU = 0;
constexpr size_t W_GU_SZ = (size_t)5632 * 1024 * 2;
constexpr size_t W_DN = W_GU + 4 * W_GU_SZ;
constexpr size_t W_DN_SZ = (size_t)1024 * 2816 * 2;
constexpr size_t W_IN0 = W_DN + 4 * W_DN_SZ;
constexpr size_t W_OUT0 = W_IN0 + (size_t)3072 * 1024 * 2;
constexpr size_t W_IN1 = W_OUT0 + (size_t)1024 * 1024 * 2;
constexpr size_t W_QUP = W_IN1 + (size_t)768 * 1024 * 2;
constexpr size_t W_KVUP = W_QUP + (size_t)1536 * 384 * 2;
constexpr size_t W_OUT1 = W_KVUP + (size_t)2048 * 256 * 2;
constexpr size_t WS_XB = W_OUT1 + (size_t)1024 * 1024 * 2;
constexpr size_t WS_SSP = WS_XB + (size_t)MT * D * 2;
constexpr size_t WS_SSC = WS_SSP + (size_t)MT * 16 * 4;
constexpr size_t WS_ROPE = WS_SSC + (size_t)MT * 24 * 4;
constexpr size_t WS_SSPS = WS_ROPE + (size_t)2048 * 16 * 8;
constexpr size_t WS_SSCS = WS_SSPS + (size_t)TS * 64 * 4;
constexpr size_t WS_M = al256(WS_SSCS + (size_t)TS * 40 * 4);
constexpr size_t WS_ACT = WS_M;
constexpr size_t QKV_SZ = (size_t)MT * 512 * 2;
constexpr size_t WS_O = WS_M;
constexpr size_t WS_QA = WS_O + (size_t)MT * D * 2, WS_KA = WS_QA + QKV_SZ, WS_VA = WS_KA + QKV_SZ, WS_QB = WS_VA + QKV_SZ, WS_KB = WS_QB + QKV_SZ, WS_VB = WS_KB + QKV_SZ;
constexpr size_t WS_KAS = WS_VB + QKV_SZ, KAS_SZ = (size_t)NB * KA_ROWS * 512 * 2, WS_VAS = WS_KAS + KAS_SZ;
constexpr size_t WS_KBS = WS_VAS + KAS_SZ, KBS_SZ = (size_t)NB * KB_ROWS * 512 * 2, WS_VBS = WS_KBS + KBS_SZ;
constexpr size_t WS_OT1 = WS_VBS + KBS_SZ;
constexpr size_t WS_L0_END = WS_OT1 + QKV_SZ;
constexpr size_t WS_CQ = WS_M;
constexpr size_t WS_CKVN = WS_CQ + (size_t)MT * 384 * 2;
static_assert(WS_CKVN + (size_t)(MKV + 128) * 256 * 2 <= WS_M + (size_t)MT * D * 2, "cq|ckvn inside the O overlay");
constexpr size_t WS_KRB = WS_O + (size_t)MT * D * 2;
constexpr size_t WS_QC = al256(WS_KRB + (size_t)(MKV + 128) * 32 * 2);
constexpr size_t WS_KVC = WS_QC + (size_t)MT * 1536 * 2;
constexpr size_t WS_L1_END = WS_KVC + ((size_t)NB * 16 * SEQ * 128 + (size_t)NB * 16 * 1040 * 128 + 128 * 128) * 2;
constexpr size_t WS_END = WS_L1_END > WS_L0_END ? WS_L1_END : WS_L0_END;
constexpr int XCD_BAR_WORDS_C = 3456;
constexpr size_t WS_CTL = al256(WS_END), CTL_BYTES = 16384;
static_assert(WS_CTL + CTL_BYTES <= (size_t)512 * 1024 * 1024, "d_ws map exceeds 512 MiB");
static_assert(XCD_BAR_WORDS_C * 4 <= CTL_BYTES, "ctl");
static_assert(WS_ACT + (size_t)MT * FF * 2 <= WS_END, "act inside the mixer region");

constexpr int LDS_BYTES = 132096;

struct Params { const float* in[31]; float* out; unsigned char* ws; int ph_lo, ph_hi; };

__device__ __forceinline__ int opq_tid() { int t = threadIdx.x; asm volatile("" : "+v"(t)); return t; }
__device__ __forceinline__ int opq_bid() { int b = blockIdx.x; asm volatile("" : "+s"(b)); return b; }
__device__ __forceinline__ float fast_exp2(float x) { return __builtin_amdgcn_exp2f(x); }
__device__ __forceinline__ float fadd_s(float a, float b) { float r; asm("v_add_f32_e32 %0, %1, %2" : "=v"(r) : "v"(a), "v"(b)); return r; }
__device__ __forceinline__ float fsub_s(float a, float b) { float r; asm("v_sub_f32_e32 %0, %1, %2" : "=v"(r) : "v"(a), "v"(b)); return r; }
__device__ __forceinline__ float fmul_s(float a, float b) { float r; asm("v_mul_f32_e32 %0, %1, %2" : "=v"(r) : "v"(a), "v"(b)); return r; }
typedef float f32x2c __attribute__((ext_vector_type(2))); typedef __bf16 bf16x2c __attribute__((ext_vector_type(2)));
__device__ __forceinline__ unsigned cvtpk_c(float lo, float hi) { f32x2c v = {lo, hi}; bf16x2c b = __builtin_convertvector(v, bf16x2c); return __builtin_bit_cast(unsigned, b); }
__device__ __forceinline__ u32x4 pack8_c(const f32x4 a, const f32x4 b) {
    u32x4 w; w.x = cvtpk_c(a[0], a[1]); w.y = cvtpk_c(a[2], a[3]); w.z = cvtpk_c(b[0], b[1]); w.w = cvtpk_c(b[2], b[3]); return w;
}
__device__ __forceinline__ float max3f(float a, float b, float c) { float r; asm("v_max3_f32 %0, %1, %2, %3" : "=v"(r) : "v"(a), "v"(b), "v"(c)); return r; }
__device__ __forceinline__ float wave_sum(float v) {
#pragma unroll
    for (int o = 32; o > 0; o >>= 1) v += __shfl_xor(v, o);
    return v;
}
__device__ __forceinline__ float rs_from(const float* p, int n4, float inv_n) {
    float s = 0.f;
    for (int i = 0; i < n4; ++i) { const f32x4 v = *(const f32x4*)(p + 4 * i); s += (v[0] + v[1]) + (v[2] + v[3]); }
    return rsqrtf(s * inv_n + EPS);
}
__device__ __forceinline__ void unpack8(const u32x4 w, f32x4& a, f32x4& b) {
    a[0] = __uint_as_float(w.x << 16); a[1] = __uint_as_float(w.x & 0xffff0000u); a[2] = __uint_as_float(w.y << 16); a[3] = __uint_as_float(w.y & 0xffff0000u);
    b[0] = __uint_as_float(w.z << 16); b[1] = __uint_as_float(w.z & 0xffff0000u); b[2] = __uint_as_float(w.w << 16); b[3] = __uint_as_float(w.w & 0xffff0000u);
}
__device__ __forceinline__ void st_nt(float* p, const f32x4 v) { __builtin_nontemporal_store(v, (f32x4*)p); }
__device__ __forceinline__ f32x4 ld_nt(const float* p) { return __builtin_nontemporal_load((const f32x4*)p); }
__device__ __forceinline__ u32x4 pack8(const f32x4 a, const f32x4 b) {
    u32x4 w; w.x = cvt_pk_bf16(a[0], a[1]); w.y = cvt_pk_bf16(a[2], a[3]); w.z = cvt_pk_bf16(b[0], b[1]); w.w = cvt_pk_bf16(b[2], b[3]); return w;
}

typedef const f32x4 (&AccRef)[2][2][4][2];

struct EpiSwiglu { static constexpr int ID = 0;
    static constexpr bool PERM = true, AFTER_DRAIN = false;
    bf16_t* act; const float* ssp;
    __device__ __forceinline__ void operator()(AccRef acc, const pg8::Unit& u, int wr, int wc, int fr, int fq) const {
        const int row0 = u.pm * 256 + wr * 64 + fr, col0 = u.pn * 128 + wc * 32 + 8 * fq;
#pragma unroll
        for (int ai = 0; ai < 2; ++ai)
#pragma unroll
            for (int m = 0; m < 4; ++m) {
                const int row = row0 + ai * 128 + m * 16;
                const float rs = rs_from(ssp + (size_t)row * 16, 4, 1.0f / 1024.0f);
                f32x4 o[2];
#pragma unroll
                for (int n = 0; n < 2; ++n)
#pragma unroll
                    for (int j = 0; j < 4; ++j) {
                        const float g = acc[ai][0][m][n][j] * rs, up = acc[ai][1][m][n][j] * rs;
                        o[n][j] = g * __builtin_amdgcn_rcpf(1.0f + __expf(-g)) * up;
                    }
                *(u32x4*)(act + (size_t)row * FF + col0) = pack8(o[0], o[1]);
            }
    }
};

struct EpiResid { static constexpr int ID = 1;
    static constexpr bool PERM = true, AFTER_DRAIN = false;
    float* x; bf16_t* xb; float* ssp; float alpha;
    __device__ __forceinline__ void operator()(AccRef acc, const pg8::Unit& u, int wr, int wc, int fr, int fq) const {
        const int row0 = u.pm * 256 + wr * 64 + fr, col0 = u.pn * 256 + wc * 32 + 8 * fq;
#pragma unroll
        for (int ai = 0; ai < 2; ++ai)
#pragma unroll
            for (int m = 0; m < 4; ++m) {
                const int row = row0 + ai * 128 + m * 16; float ss = 0.f;
#pragma unroll
                for (int bj = 0; bj < 2; ++bj) {
                    bf16_t* xp = xb + (size_t)row * D + col0 + bj * 128;
                    f32x4 a, b; unpack8(*(const u32x4*)xp, a, b);
                    a += acc[ai][bj][m][0] * alpha; b += acc[ai][bj][m][1] * alpha;
                    *(u32x4*)xp = pack8(a, b);
                    ss += (a[0] * a[0] + a[1] * a[1]) + (a[2] * a[2] + a[3] * a[3]) + (b[0] * b[0] + b[1] * b[1]) + (b[2] * b[2] + b[3] * b[3]);
                }
                ss += __shfl_xor(ss, 16); ss += __shfl_xor(ss, 32);
                if (fq == 0) ssp[(size_t)row * 16 + u.pn * 4 + wc] = ss;
            }
    }
};

struct EpiIn0 { static constexpr int ID = 2;
    static constexpr bool PERM = true, AFTER_DRAIN = false;
    const float* ssp; unsigned char* ws; float* out;
    __device__ __forceinline__ void operator()(AccRef acc, const pg8::Unit& u, int wr, int wc, int fr, int fq) const {
        const int sec = u.pn >> 1;
        const int row0 = u.pm * 256 + wr * 64 + fr, cs0 = (u.pn & 1) * 256 + wc * 32 + 8 * fq;
        const bool sample = (u.pm == 128);
        bf16_t* tok = (bf16_t*)(ws + WS_QA + (size_t)sec * QKV_SZ);
        const float qs = (sec == 0 || sec == 3) ? QS_AB : 1.0f;
#pragma unroll
        for (int ai = 0; ai < 2; ++ai)
#pragma unroll
            for (int m = 0; m < 4; ++m) {
                const int row = row0 + ai * 128 + m * 16;
                const float rs = rs_from(ssp + (size_t)row * 16, 4, 1.0f / 1024.0f);
                const float sc = rs * qs;
#pragma unroll
                for (int bj = 0; bj < 2; ++bj) {
                    const int cs = cs0 + bj * 128;
                    const f32x4 a = acc[ai][bj][m][0] * sc, b = acc[ai][bj][m][1] * sc;
                    const u32x4 w = pack8(a, b);
                    *(u32x4*)(tok + (size_t)row * 512 + cs) = w;
                    if (sec == 0 || sec == 3) continue;
                    float* fo = nullptr;
                    if (!sample) {
                        const int b_ = row >> 11, t = row & 2047;
                        if (sec == 1 || sec == 2) { if ((u.pm & 7) >= 6) fo = out + (sec == 1 ? O_PAK : O_PAV) + ((size_t)b_ * 512 + (t - 1536)) * 512 + cs; }
                        else fo = out + (sec == 4 ? O_PBK : O_PBV) + (size_t)row * 512 + cs;
                    } else {
                        const int sr = row - TP, b_ = sr >> 4, t = sr & 15;
                        const size_t so = (sec == 1) ? O_SAK : (sec == 2) ? O_SAV : (sec == 4) ? O_SBK : O_SBV;
                        fo = out + so + (size_t)sr * 512 + cs;
                        bf16_t* cat = (sec == 1) ? (bf16_t*)(ws + WS_KAS) + ((size_t)b_ * KA_ROWS + 512 + t) * 512
                                    : (sec == 2) ? (bf16_t*)(ws + WS_VAS) + ((size_t)b_ * KA_ROWS + 512 + t) * 512
                                    : (sec == 4) ? (bf16_t*)(ws + WS_KBS) + ((size_t)b_ * KB_ROWS + 1024 + t) * 512
                                                 : (bf16_t*)(ws + WS_VBS) + ((size_t)b_ * KB_ROWS + 1024 + t) * 512;
                        *(u32x4*)(cat + cs) = w;
                    }
                    if (fo) { st_nt(fo, a); st_nt(fo + 4, b); }
                }
            }
    }
};

struct EpiIn1 { static constexpr int ID = 3;
    static constexpr bool PERM = true, AFTER_DRAIN = false;
    const float* ssp; unsigned char* ws; float* out;
    __device__ __forceinline__ void operator()(AccRef acc, const pg8::Unit& u, int wr, int wc, int fr, int fq) const {
        const int row0 = u.pm * 256 + wr * 64 + fr;
        const bool sample = (u.pm == 128);
        bf16_t* cq = (bf16_t*)(ws + WS_CQ); float* ssc = (float*)(ws + WS_SSC);
#pragma unroll
        for (int ai = 0; ai < 2; ++ai)
#pragma unroll
            for (int m = 0; m < 4; ++m) {
                const int row = row0 + ai * 128 + m * 16;
                const float rs = rs_from(ssp + (size_t)row * 16, 4, 1.0f / 1024.0f);
#pragma unroll
                for (int bj = 0; bj < 2; ++bj) {
                    const int c = u.pn * 256 + bj * 128 + wc * 32 + 8 * fq;
                    const f32x4 a = acc[ai][bj][m][0] * rs, b = acc[ai][bj][m][1] * rs;
                    float ss = (a[0] * a[0] + a[1] * a[1]) + (a[2] * a[2] + a[3] * a[3]) + (b[0] * b[0] + b[1] * b[1]) + (b[2] * b[2] + b[3] * b[3]);
                    ss += __shfl_xor(ss, 16); ss += __shfl_xor(ss, 32);
                    const int part = u.pn * 2 + bj;
                    if (part < 5 && fq == 0) ssc[(size_t)row * 24 + part * 4 + wc] = ss;
                    if (part < 3) { *(u32x4*)(cq + (size_t)row * 384 + c) = pack8(a, b); }
                    else if (part < 5) {
                        float* fo = sample ? out + O_SCKV + (size_t)(row - TP) * 256 + (c - 384) : out + O_PCKV + (size_t)row * 256 + (c - 384);
                        *(f32x4*)fo = a; *(f32x4*)(fo + 4) = b;
                    } else if (wc == 0) {
                        float* fo = sample ? out + O_SCKR + (size_t)(row - TP) * 32 + (c - 640) : out + O_PCKR + (size_t)row * 32 + (c - 640);
                        *(f32x4*)fo = a; *(f32x4*)(fo + 4) = b;
                    }
                }
            }
    }
};

struct EpiQup { static constexpr int ID = 4;
    static constexpr bool PERM = true, AFTER_DRAIN = false;
    unsigned char* ws;
    __device__ __forceinline__ void operator()(AccRef acc, const pg8::Unit& u, int wr, int wc, int fr, int fq) const {
        const int row0 = u.pm * 256 + wr * 64 + fr;
        const float* ssc = (const float*)(ws + WS_SSC); bf16_t* qc = (bf16_t*)(ws + WS_QC); const float* rope = (const float*)(ws + WS_ROPE);
#pragma unroll
        for (int ai = 0; ai < 2; ++ai)
#pragma unroll
            for (int m = 0; m < 4; ++m) {
                const int row = row0 + ai * 128 + m * 16;
                const float rs = rs_from(ssc + (size_t)row * 24, 3, 1.0f / 384.0f) * QS_C;
                const int pos = row < TP ? (row & 2047) : PAST + ((row - TP) & 15);
#pragma unroll
                for (int bj = 0; bj < 2; ++bj) {
                    const int c = u.pn * 256 + bj * 128 + wc * 32 + 8 * fq;
                    const int o = c % 96;
                    f32x4 a = acc[ai][bj][m][0] * rs, b = acc[ai][bj][m][1] * rs;
                    if (o >= 64) {
                        const int i0 = (o - 64) >> 1;
                        const f32x4 cs0 = *(const f32x4*)(rope + ((size_t)pos * 16 + i0) * 2), cs1 = *(const f32x4*)(rope + ((size_t)pos * 16 + i0 + 2) * 2);
                        f32x4 a2, b2;
                        a2[0] = a[0] * cs0[0] - a[1] * cs0[1]; a2[1] = a[0] * cs0[1] + a[1] * cs0[0];
                        a2[2] = a[2] * cs0[2] - a[3] * cs0[3]; a2[3] = a[2] * cs0[3] + a[3] * cs0[2];
                        b2[0] = b[0] * cs1[0] - b[1] * cs1[1]; b2[1] = b[0] * cs1[1] + b[1] * cs1[0];
                        b2[2] = b[2] * cs1[2] - b[3] * cs1[3]; b2[3] = b[2] * cs1[3] + b[3] * cs1[2];
                        a = a2; b = b2;
                    }
                    *(u32x4*)(qc + (size_t)row * 1536 + c) = pack8(a, b);
                }
            }
    }
};

constexpr int KC_ROWS = 1040;
constexpr size_t KVC_S_OFF = (size_t)NB * 16 * SEQ * 128;
struct EpiKvHead { static constexpr int ID = 6;
    static constexpr bool PERM = true, AFTER_DRAIN = false;
    bf16_t* O;
    __device__ __forceinline__ void operator()(AccRef acc, const pg8::Unit& u, int wr, int wc, int fr, int fq) const {
        const int row0 = u.pm * 256 + wr * 64 + fr, col0 = u.pn * 256 + wc * 32 + 8 * fq;
        asm volatile("s_nop 15" ::: "memory");
#pragma unroll
        for (int ai = 0; ai < 2; ++ai)
#pragma unroll
            for (int m = 0; m < 4; ++m) {
                const int row = row0 + ai * 128 + m * 16; size_t base; long stride;
                if (row < TP) { base = ((size_t)(row >> 11) * 16 * SEQ + (row & 2047)) * 128; stride = (long)SEQ * 128; }
                else { const int sr = row - TP, b_ = sr / (PAST + NEW), pos = sr - b_ * (PAST + NEW); base = KVC_S_OFF + ((size_t)b_ * 16 * KC_ROWS + pos) * 128; stride = (long)KC_ROWS * 128; }
#pragma unroll
                for (int bj = 0; bj < 2; ++bj) { const int c = col0 + bj * 128;
                    *(u32x4*)(O + base + (size_t)(c >> 7) * stride + (c & 127)) = pack8_c(acc[ai][bj][m][0], acc[ai][bj][m][1]); }
            }
    }
};
struct EpiPlain { static constexpr int ID = 5;
    static constexpr bool PERM = true, AFTER_DRAIN = false;
    bf16_t* O; int ldc;
    __device__ __forceinline__ void operator()(AccRef acc, const pg8::Unit& u, int wr, int wc, int fr, int fq) const {
        const int row0 = u.pm * 256 + wr * 64 + fr, col0 = u.pn * 256 + wc * 32 + 8 * fq;
#pragma unroll
        for (int ai = 0; ai < 2; ++ai)
#pragma unroll
            for (int m = 0; m < 4; ++m)
#pragma unroll
                for (int bj = 0; bj < 2; ++bj)
                    *(u32x4*)(O + (size_t)(row0 + ai * 128 + m * 16) * ldc + col0 + bj * 128) = pack8_c(acc[ai][bj][m][0], acc[ai][bj][m][1]);
    }
};

template <class Epi> __device__ __forceinline__ void run_gemm(LAS unsigned char* lds, const bf16_t* A, const bf16_t* Bt, int M, int N, int K, const Epi& E) {
    asm volatile("" : "+s"(K));
    pg8::Gemm g{A, Bt, M, N, K}; pg8::StaticOrder S; S.init(M, N, (int)gridDim.x, (int)blockIdx.x);
#ifdef ONLY_G
    if constexpr (Epi::ID != ONLY_G) return;
#endif
#ifndef DIS_G
    pg8::gemm_phase<Epi, pg8::StaticOrder, true, true>(lds, g, S, E);
#endif
}


template <int NG, int UNR, class Epi, int KS = 1> __device__ __forceinline__ void skinny_gemm(const bf16_t* A, const bf16_t* Bt, int K, int ngroups, const Epi& E, int bshift = 0, LAS unsigned char* lds = nullptr) {
    const int tid = opq_tid(), lane = tid & 63, w = tid >> 6, rr = lane & 15, kq = lane >> 4;
    const int rg = KS == 2 ? (w & 3) : w, kh = KS == 2 ? (w >> 2) : 0, KL = K / KS;
    for (int u = (opq_bid() + (int)gridDim.x - bshift) % (int)gridDim.x; u < 2 * KS * ngroups; u += gridDim.x) {
        const int hv = u & (2 * KS - 1), cg = u / (2 * KS), srow = hv * (128 / KS) + rg * 16 + rr;
        const bf16_t* ap = A + (size_t)srow * K + kh * KL + 8 * kq;
        const bf16_t* bp[NG]; f32x4 acc[NG];
#pragma unroll
        for (int g = 0; g < NG; ++g) { bp[g] = Bt + (size_t)(Epi::brow(cg, g) + rr) * K + kh * KL + 8 * kq; acc[g] = (f32x4){0.f, 0.f, 0.f, 0.f}; }
        bf16x8 a0[UNR], a1[UNR], b0[NG][UNR], b1[NG][UNR];
#define SK_LOAD(AR, BR, k0) do { _Pragma("unroll") for (int i = 0; i < UNR; ++i) { AR[i] = *(const bf16x8*)(ap + (k0) + 32 * i); \
            _Pragma("unroll") for (int g = 0; g < NG; ++g) BR[g][i] = *(const bf16x8*)(bp[g] + (k0) + 32 * i); } } while (0)
#define SK_MMA(AR, BR) do { _Pragma("unroll") for (int i = 0; i < UNR; ++i) _Pragma("unroll") for (int g = 0; g < NG; ++g) acc[g] = __builtin_amdgcn_mfma_f32_16x16x32_bf16(BR[g][i], AR[i], acc[g], 0, 0, 0); } while (0)
        SK_LOAD(a0, b0, 0);
        for (int k = 0; k < KL; k += 64 * UNR) {
            SK_LOAD(a1, b1, k + 32 * UNR);
            SK_MMA(a0, b0);
            if (k + 64 * UNR < KL) SK_LOAD(a0, b0, k + 64 * UNR);
            SK_MMA(a1, b1);
        }
#undef SK_LOAD
#undef SK_MMA
        if constexpr (KS == 2) {
            LAS f32x4* xch = (LAS f32x4*)lds;
            if (kh == 1) xch[rg * 64 + lane] = acc[0] + (f32x4){0.f, 0.f, 0.f, 0.f};
            __syncthreads();
            if (kh == 0) { acc[0] += xch[rg * 64 + lane]; E(acc, srow, cg, kq); }
            __syncthreads();
        } else E(acc, srow, cg, kq);
    }
}
__device__ __forceinline__ float rs_sample(const float* ssps, int srow) { return rs_from(ssps + (size_t)srow * 64, 16, 1.0f / 1024.0f); }

struct SkSwiglu { static __device__ __forceinline__ int brow(int cg, int g) { return 256 * (cg >> 3) + 16 * (cg & 7) + 128 * g; }
    bf16_t* act; const float* ssps;
    __device__ __forceinline__ void operator()(const f32x4 (&acc)[2], int srow, int cg, int kq) const {
        const float rs = rs_sample(ssps, srow); f32x4 o;
#pragma unroll
        for (int j = 0; j < 4; ++j) { const float g = acc[0][j] * rs, up = acc[1][j] * rs; o[j] = g * __builtin_amdgcn_rcpf(1.0f + __expf(-g)) * up; }
        u32x2 w; w.x = cvt_pk_bf16(o[0], o[1]); w.y = cvt_pk_bf16(o[2], o[3]);
        *(u32x2*)(act + (size_t)(TP + srow) * FF + cg * 16 + 4 * kq) = w;
    }
};
struct SkSwiglu4 { static __device__ __forceinline__ int brow(int cgp, int g) { const int cg = 2 * cgp + (g >> 1); return 256 * (cg >> 3) + 16 * (cg & 7) + 128 * (g & 1); }
    bf16_t* act; const float* ssps;
    __device__ __forceinline__ void operator()(const f32x4 (&acc)[4], int srow, int cgp, int kq) const {
        const float rs = rs_sample(ssps, srow);
#pragma unroll
        for (int q = 0; q < 2; ++q) { f32x4 o;
#pragma unroll
            for (int j = 0; j < 4; ++j) { const float g = acc[2 * q][j] * rs, up = acc[2 * q + 1][j] * rs; o[j] = g * __builtin_amdgcn_rcpf(1.0f + __expf(-g)) * up; }
            u32x2 w; w.x = cvt_pk_bf16(o[0], o[1]); w.y = cvt_pk_bf16(o[2], o[3]);
            *(u32x2*)(act + (size_t)(TP + srow) * FF + (2 * cgp + q) * 16 + 4 * kq) = w; }
    }
};
struct SkResid { static __device__ __forceinline__ int brow(int cg, int) { return 16 * cg; }
    float* x; bf16_t* xb; float* ssps; float alpha;
    __device__ __forceinline__ void operator()(const f32x4 (&acc)[1], int srow, int cg, int kq) const {
        bf16_t* xp = xb + (size_t)(TP + srow) * D + cg * 16 + 4 * kq;
        const u32x2 w0 = *(const u32x2*)xp; f32x4 a;
        a[0] = __uint_as_float(w0.x << 16); a[1] = __uint_as_float(w0.x & 0xffff0000u); a[2] = __uint_as_float(w0.y << 16); a[3] = __uint_as_float(w0.y & 0xffff0000u);
        a += acc[0] * alpha;
        u32x2 w; w.x = cvt_pk_bf16(a[0], a[1]); w.y = cvt_pk_bf16(a[2], a[3]);
        *(u32x2*)xp = w;
        float ss = (a[0] * a[0] + a[1] * a[1]) + (a[2] * a[2] + a[3] * a[3]);
        ss += __shfl_xor(ss, 16); ss += __shfl_xor(ss, 32);
        if (kq == 0) ssps[(size_t)srow * 64 + cg] = ss;
    }
};
struct SkIn0 { static __device__ __forceinline__ int brow(int cgp, int g) { return 16 * (2 * cgp + g); }
    const float* ssps; unsigned char* ws; float* out;
    __device__ __forceinline__ void operator()(const f32x4 (&acc)[2], int srow, int cgp, int kq) const { one(acc[0], srow, 2 * cgp, kq); one(acc[1], srow, 2 * cgp + 1, kq); }
    __device__ __forceinline__ void one(const f32x4 acc0, int srow, int cg, int kq) const {
        const int sec = cg >> 5, cs = (cg & 31) * 16 + 4 * kq, b_ = srow >> 4, t = srow & 15;
        const float sc = rs_sample(ssps, srow) * ((sec == 0 || sec == 3) ? QS_AB : 1.0f);
        const f32x4 a = acc0 * sc;
        u32x2 w; w.x = cvt_pk_bf16(a[0], a[1]); w.y = cvt_pk_bf16(a[2], a[3]);
        *(u32x2*)((bf16_t*)(ws + WS_QA + (size_t)sec * QKV_SZ) + (size_t)(TP + srow) * 512 + cs) = w;
        if (sec == 0 || sec == 3) return;
        const size_t so = (sec == 1) ? O_SAK : (sec == 2) ? O_SAV : (sec == 4) ? O_SBK : O_SBV;
        *(f32x4*)(out + so + (size_t)srow * 512 + cs) = a;
        bf16_t* cat = (sec == 1) ? (bf16_t*)(ws + WS_KAS) + ((size_t)b_ * KA_ROWS + 512 + t) * 512
                    : (sec == 2) ? (bf16_t*)(ws + WS_VAS) + ((size_t)b_ * KA_ROWS + 512 + t) * 512
                    : (sec == 4) ? (bf16_t*)(ws + WS_KBS) + ((size_t)b_ * KB_ROWS + 1024 + t) * 512
                                 : (bf16_t*)(ws + WS_VBS) + ((size_t)b_ * KB_ROWS + 1024 + t) * 512;
        *(u32x2*)(cat + cs) = w;
    }
};
struct SkIn1 { static __device__ __forceinline__ int brow(int cg, int) { return 16 * cg; }
    const float* ssps; unsigned char* ws; float* out;
    __device__ __forceinline__ void operator()(const f32x4 (&acc)[1], int srow, int cg, int kq) const {
        const f32x4 a = acc[0] * rs_sample(ssps, srow);
        float ss = (a[0] * a[0] + a[1] * a[1]) + (a[2] * a[2] + a[3] * a[3]);
        ss += __shfl_xor(ss, 16); ss += __shfl_xor(ss, 32);
        if (cg < 40 && kq == 0) ((float*)(ws + WS_SSCS))[(size_t)srow * 40 + cg] = ss;
        const int c = cg * 16 + 4 * kq;
        if (cg < 24) { u32x2 w; w.x = cvt_pk_bf16(a[0], a[1]); w.y = cvt_pk_bf16(a[2], a[3]); *(u32x2*)((bf16_t*)(ws + WS_CQ) + (size_t)(TP + srow) * 384 + c) = w; }
        else if (cg < 40) *(f32x4*)(out + O_SCKV + (size_t)srow * 256 + (c - 384)) = a;
        else *(f32x4*)(out + O_SCKR + (size_t)srow * 32 + (c - 640)) = a;
    }
};
struct SkPlain { static __device__ __forceinline__ int brow(int cg, int) { return 16 * cg; }
    bf16_t* O; int ldc;
    __device__ __forceinline__ void operator()(const f32x4 (&acc)[1], int srow, int cg, int kq) const {
        u32x2 w; w.x = cvt_pk_bf16(acc[0][0], acc[0][1]); w.y = cvt_pk_bf16(acc[0][2], acc[0][3]);
        *(u32x2*)(O + (size_t)srow * ldc + cg * 16 + 4 * kq) = w;
    }
};
struct SkKvHead { static __device__ __forceinline__ int brow(int cg, int) { return 16 * cg; }
    bf16_t* O;
    __device__ __forceinline__ void operator()(const f32x4 (&acc)[1], int srow, int cg, int kq) const {
        const int sr = (MKV - 256 - TP) + srow, b_ = sr / (PAST + NEW), pos = sr - b_ * (PAST + NEW), c = cg * 16 + 4 * kq;
        u32x2 w; w.x = cvtpk_c(acc[0][0], acc[0][1]); w.y = cvtpk_c(acc[0][2], acc[0][3]);
        *(u32x2*)(O + KVC_S_OFF + (((size_t)b_ * 16 + (c >> 7)) * KC_ROWS + pos) * 128 + (c & 127)) = w;
    }
};
struct SkQup { static __device__ __forceinline__ int brow(int cg, int) { return 16 * cg; }
    unsigned char* ws;
    __device__ __forceinline__ void operator()(const f32x4 (&acc)[1], int srow, int cg, int kq) const {
        const float rs = rs_from((const float*)(ws + WS_SSCS) + (size_t)srow * 40, 6, 1.0f / 384.0f) * QS_C;
        const int c = cg * 16 + 4 * kq, o = c % 96, pos = PAST + (srow & 15);
        f32x4 a = acc[0] * rs;
        if (o >= 64) {
            const int i0 = (o - 64) >> 1;
            const f32x4 cs0 = *(const f32x4*)((const float*)(ws + WS_ROPE) + ((size_t)pos * 16 + i0) * 2);
            f32x4 a2; a2[0] = a[0] * cs0[0] - a[1] * cs0[1]; a2[1] = a[0] * cs0[1] + a[1] * cs0[0]; a2[2] = a[2] * cs0[2] - a[3] * cs0[3]; a2[3] = a[2] * cs0[3] + a[3] * cs0[2];
            a = a2;
        }
        u32x2 w; w.x = cvt_pk_bf16(a[0], a[1]); w.y = cvt_pk_bf16(a[2], a[3]);
        *(u32x2*)((bf16_t*)(ws + WS_QC) + (size_t)(TP + srow) * 1536 + c) = w;
    }
};

__device__ __forceinline__ void convert_weight(LAS unsigned char* lds, const float* W, bf16_t* Bt, int K, int Nsrc, int Ndst, const float* gain, int mode) {
    LAS float* tile = (LAS float*)lds;
    const int tid = opq_tid(), nkt = K / 64, nnt = Ndst / 64;
    for (int t = opq_bid(); t < nkt * nnt; t += gridDim.x) {
        const int k0 = (t % nkt) * 64, n0 = (t / nkt) * 64;
#pragma unroll
        for (int i = 0; i < 8; ++i) {
            const int e = tid + i * 512, kk = e >> 6, nn = e & 63, np = n0 + nn; int n;
            if (mode == 1) { const int pn = np >> 8, bj = (np >> 7) & 1, c = np & 127; n = bj * FF + pn * 128 + c; }
            else if (mode == 2) { const int h = np / 96, o = np % 96; n = o < 64 ? np : h * 96 + 64 + ((o - 64) & 1) * 16 + ((o - 64) >> 1); }
            else n = np;
            float v = 0.f;
            if (n < Nsrc) { v = W[(size_t)(k0 + kk) * Nsrc + n]; if (gain) v *= gain[k0 + kk]; }
            tile[kk * 65 + nn] = v;
        }
        __syncthreads();
#pragma unroll
        for (int i = 0; i < 4; ++i) {
            const int e = tid + i * 512, nn = e >> 5, kp = e & 31;
            *(unsigned*)(Bt + (size_t)(n0 + nn) * K + k0 + 2 * kp) = cvt_pk_bf16(tile[(2 * kp) * 65 + nn], tile[(2 * kp + 1) * 65 + nn]);
        }
        __syncthreads();
    }
}


__device__ __forceinline__ void convert_weight_v4(LAS unsigned char* lds, const float* W, bf16_t* Bt, int K, int Nsrc, int Ndst, const float* gain, int mode) {
    LAS float* tile = (LAS float*)lds;
    const int tid = opq_tid(), nkt = K / 64, nnt = Ndst / 256;
    for (int t = opq_bid(); t < nkt * nnt; t += gridDim.x) {
        const int k0 = (t % nkt) * 64, pn = t / nkt, n0 = pn * 256;
        f32x4 v[8];
#pragma unroll
        for (int i = 0; i < 8; ++i) {
            const int e = tid + i * 512, kk = e >> 6, n4 = e & 63;
            const int n = (mode == 1) ? (n4 >> 5) * FF + pn * 128 + (n4 & 31) * 4 : n0 + n4 * 4;
            v[i] = (f32x4){0.f, 0.f, 0.f, 0.f};
            if (n < Nsrc) v[i] = ld_nt(W + (size_t)(k0 + kk) * Nsrc + n);
        }
#pragma unroll
        for (int i = 0; i < 8; ++i) {
            const int e = tid + i * 512, kk = e >> 6, n4 = e & 63;
            const float g = gain ? gain[k0 + kk] : 1.0f;
#pragma unroll
            for (int j = 0; j < 4; ++j) tile[kk * 257 + n4 * 4 + j] = v[i][j] * g;
        }
        __syncthreads();
#pragma unroll
        for (int i = 0; i < 8; ++i) {
            const int e = tid + i * 512, nn = e >> 4, kq = e & 15;
            u32x2 w; w.x = cvt_pk_bf16(tile[(4 * kq) * 257 + nn], tile[(4 * kq + 1) * 257 + nn]); w.y = cvt_pk_bf16(tile[(4 * kq + 2) * 257 + nn], tile[(4 * kq + 3) * 257 + nn]);
            *(u32x2*)(Bt + (size_t)(n0 + nn) * K + k0 + 4 * kq) = w;
        }
        __syncthreads();
    }
}

__device__ __forceinline__ void convert_rows(const float* src, bf16_t* dst, int R, int W, int per, int stride, int off, int vb = -1, int nb = 0) {
    if (vb < 0) { vb = opq_bid(); nb = (int)gridDim.x; }
    const int cpr = W / 8; const long total = (long)R * cpr, step = (long)nb * 512;
    for (long c0 = (long)vb * 512 + opq_tid(); c0 < total; c0 += 4 * step) {
        f32x4 a[4], b[4];
#pragma unroll
        for (int q = 0; q < 4; ++q) { const long c = c0 + q * step; if (c < total) { const long r = c / cpr; const int c8 = (int)(c % cpr);
            a[q] = ld_nt(src + (size_t)r * W + c8 * 8); b[q] = ld_nt(src + (size_t)r * W + c8 * 8 + 4); } }
#pragma unroll
        for (int q = 0; q < 4; ++q) { const long c = c0 + q * step; if (c < total) { const int r = (int)(c / cpr), c8 = (int)(c % cpr);
            const size_t dr = (size_t)(r / per) * stride + off + (r % per);
            *(u32x4*)(dst + dr * W + c8 * 8) = pack8(a[q], b[q]); } }
    }
}

__device__ __forceinline__ void prologue(LAS unsigned char* lds, const Params& P) {
    unsigned char* ws = P.ws; const float* const* in = P.in;
    const int tid = opq_tid(), lane = tid & 63, gw = opq_bid() * 8 + (tid >> 6), nw = gridDim.x * 8;
    for (int l = 0; l < 2; ++l) {
        convert_weight_v4(lds, in[10] + (size_t)l * D * 2 * FF, (bf16_t*)(ws + W_GU + (size_t)(l * 2 + 0) * W_GU_SZ), D, 2 * FF, 2 * FF, in[9] + l * D, 1);
        convert_weight_v4(lds, in[14] + (size_t)l * D * 2 * FF, (bf16_t*)(ws + W_GU + (size_t)(l * 2 + 1) * W_GU_SZ), D, 2 * FF, 2 * FF, in[13] + l * D, 1);
        convert_weight_v4(lds, in[11] + (size_t)l * FF * D, (bf16_t*)(ws + W_DN + (size_t)(l * 2 + 0) * W_DN_SZ), FF, D, D, nullptr, 0);
        convert_weight_v4(lds, in[15] + (size_t)l * FF * D, (bf16_t*)(ws + W_DN + (size_t)(l * 2 + 1) * W_DN_SZ), FF, D, D, nullptr, 0);
    }
    convert_weight_v4(lds, in[16], (bf16_t*)(ws + W_IN0), D, 3072, 3072, in[12], 0);
    convert_weight_v4(lds, in[23], (bf16_t*)(ws + W_OUT0), D, D, D, nullptr, 0);
    convert_weight_v4(lds, in[24], (bf16_t*)(ws + W_IN1), D, 672, 768, in[12] + D, 0);
    convert_weight(lds, in[27], (bf16_t*)(ws + W_QUP), 384, 1536, 1536, in[25], 2);
    convert_weight_v4(lds, in[28], (bf16_t*)(ws + W_KVUP), 256, 2048, 2048, nullptr, 0);
    convert_weight_v4(lds, in[29], (bf16_t*)(ws + W_OUT1), D, D, D, nullptr, 0);
    {
        bf16_t* xb = (bf16_t*)(ws + WS_XB); float* ssp = (float*)(ws + WS_SSP);
        for (int row0 = gw * 2; row0 < MT; row0 += nw * 2) {
            f32x4 a[2][2], b[2][2];
#pragma unroll
            for (int q = 0; q < 2; ++q) { const int row = row0 + q; const float* src = row < TP ? in[0] + (size_t)row * D : in[1] + (size_t)(row - TP) * D;
#pragma unroll
                for (int i = 0; i < 2; ++i) { const int c = (lane + i * 64) * 8; a[q][i] = ld_nt(src + c); b[q][i] = ld_nt(src + c + 4); } }
#pragma unroll
            for (int q = 0; q < 2; ++q) { const int row = row0 + q; float ss = 0.f;
#pragma unroll
                for (int i = 0; i < 2; ++i) { const int c = (lane + i * 64) * 8; const f32x4 av = a[q][i], bv = b[q][i];
                    *(u32x4*)(xb + (size_t)row * D + c) = pack8(av, bv);
                    ss += (av[0] * av[0] + av[1] * av[1]) + (av[2] * av[2] + av[3] * av[3]) + (bv[0] * bv[0] + bv[1] * bv[1]) + (bv[2] * bv[2] + bv[3] * bv[3]); }
                ss = wave_sum(ss);
                if (lane < 16) ssp[(size_t)row * 16 + lane] = lane == 0 ? ss : 0.f;
                if (row >= TP) ((float*)(ws + WS_SSPS))[(size_t)(row - TP) * 64 + lane] = lane == 0 ? ss : 0.f; }
        }
    }
    convert_rows(in[2], (bf16_t*)(ws + WS_KAS), NB * 512, 512, 512, KA_ROWS, 0);
    convert_rows(in[3], (bf16_t*)(ws + WS_VAS), NB * 512, 512, 512, KA_ROWS, 0);
    convert_rows(in[4], (bf16_t*)(ws + WS_KBS), NB * 1024, 512, 1024, KB_ROWS, 0);
    convert_rows(in[5], (bf16_t*)(ws + WS_VBS), NB * 1024, 512, 1024, KB_ROWS, 0);
    {
        float* rope = (float*)(ws + WS_ROPE);
        for (int e = opq_bid() * 512 + tid; e < 2048 * 16; e += gridDim.x * 512) {
            const int pos = e >> 4, i = e & 15;
            const float inv = expf(-(float)i * (9.210340371976184f / 16.0f));
            const float ang = (float)pos * inv;
            const float k = rintf(ang * 0.15915494309189535f);
            float r = fmaf(-k, 6.28125f, ang); r = fmaf(-k, 1.9353071795864769e-3f, r);
            rope[2 * e] = __cosf(r); rope[2 * e + 1] = __sinf(r);
        }
    }
}

__device__ __forceinline__ void prologue_l1(const Params& P, int vb, int nb) {
    unsigned char* ws = P.ws;
    convert_rows(P.in[6], (bf16_t*)(ws + WS_CKVN), NB * 1024, 256, 1024, PAST + NEW, TP, vb, nb);
    bf16_t* krb = (bf16_t*)(ws + WS_KRB); const float* src = P.in[7];
    for (long c = (long)vb * 512 + opq_tid(); c < (long)NB * 1024 * 4; c += (long)nb * 512) {
        const int r = (int)(c >> 2), c8 = (int)(c & 3);
        const f32x4 a = *(const f32x4*)(src + (size_t)r * 32 + c8 * 4), b = *(const f32x4*)(src + (size_t)r * 32 + 16 + c8 * 4);
        const size_t dr = (size_t)TP + (size_t)(r >> 10) * (PAST + NEW) + (r & 1023);
        u32x4 w; w.x = cvt_pk_bf16(a[0], b[0]); w.y = cvt_pk_bf16(a[1], b[1]); w.z = cvt_pk_bf16(a[2], b[2]); w.w = cvt_pk_bf16(a[3], b[3]);
        *(u32x4*)(krb + dr * 32 + c8 * 8) = w;
    }
}

__device__ __forceinline__ void thin_l1(const Params& P) {
    unsigned char* ws = P.ws;
    const int tid = opq_tid(), lane = tid & 63, gw = opq_bid() * 8 + (tid >> 6), nw = gridDim.x * 8;
    const float* ssc = (const float*)(ws + WS_SSC); const float* gkv = P.in[26]; const float* rope = (const float*)(ws + WS_ROPE);
    bf16_t* ckvn = (bf16_t*)(ws + WS_CKVN); bf16_t* krb = (bf16_t*)(ws + WS_KRB);
    const f32x4 g = *(const f32x4*)(gkv + lane * 4);
    constexpr int NR = 4;
    for (int row0 = gw; row0 < MT; row0 += NR * nw) {
        float* ckv[NR]; float* kr[NR]; size_t dr[NR]; float rs[NR]; f32x4 v[NR]; float x1[NR], x2[NR], cc[NR], sn[NR]; bool ok[NR];
#pragma unroll
        for (int q = 0; q < NR; ++q) {
            const int row = row0 + q * nw; ok[q] = row < MT; const int rw = ok[q] ? row : 0;
            const bool sample = rw >= TP; const int sr = rw - TP;
            ckv[q] = sample ? P.out + O_SCKV + (size_t)sr * 256 : P.out + O_PCKV + (size_t)rw * 256;
            kr[q] = sample ? P.out + O_SCKR + (size_t)sr * 32 : P.out + O_PCKR + (size_t)rw * 32;
            dr[q] = sample ? (size_t)TP + (size_t)(sr >> 4) * (PAST + NEW) + PAST + (sr & 15) : (size_t)rw;
            const int pos = sample ? PAST + (sr & 15) : (rw & 2047);
            rs[q] = sample ? rs_from((const float*)(ws + WS_SSCS) + (size_t)sr * 40 + 24, 4, 1.0f / 256.0f) : rs_from(ssc + (size_t)rw * 24 + 12, 2, 1.0f / 256.0f);
            v[q] = *(const f32x4*)(ckv[q] + lane * 4);
            x1[q] = kr[q][lane & 15]; x2[q] = kr[q][16 + (lane & 15)];
            cc[q] = rope[((size_t)pos * 16 + (lane & 15)) * 2]; sn[q] = rope[((size_t)pos * 16 + (lane & 15)) * 2 + 1];
        }
#pragma unroll
        for (int q = 0; q < NR; ++q) {
            if (!ok[q]) continue;
            const f32x4 o = v[q] * rs[q] * g;
            *(f32x4*)(ckv[q] + lane * 4) = o;
            u32x2 w; w.x = cvt_pk_bf16(o[0], o[1]); w.y = cvt_pk_bf16(o[2], o[3]);
            *(u32x2*)(ckvn + dr[q] * 256 + lane * 4) = w;
            if (lane < 16) {
                const float y1 = x1[q] * cc[q] - x2[q] * sn[q], y2 = x1[q] * sn[q] + x2[q] * cc[q];
                kr[q][lane] = y1; kr[q][16 + lane] = y2;
                *(unsigned*)(krb + dr[q] * 32 + 2 * lane) = cvt_pk_bf16(y1, y2);
            }
        }
    }
}

__device__ __forceinline__ void final_norm(const Params& P) {
    const int tid = opq_tid(), lane = tid & 63, gw = opq_bid() * 8 + (tid >> 6), nw = gridDim.x * 8;
    const float* ssp = (const float*)(P.ws + WS_SSP); const float* g = P.in[30]; float* x = P.out; const bf16_t* xbf = (const bf16_t*)(P.ws + WS_XB);
    for (int row = gw; row < MT; row += nw) {
        const float rs = row >= TP ? rs_sample((const float*)(P.ws + WS_SSPS), row - TP) : rs_from(ssp + (size_t)row * 16, 4, 1.0f / 1024.0f);
#pragma unroll
        for (int i = 0; i < 2; ++i) {
            const int c = (lane + i * 64) * 8;
            f32x4 a, b; unpack8(*(const u32x4*)(xbf + (size_t)row * D + c), a, b);
            const f32x4 g0 = *(const f32x4*)(g + c), g1 = *(const f32x4*)(g + c + 4);
            st_nt(x + (size_t)row * D + c, a * rs * g0); st_nt(x + (size_t)row * D + c + 4, b * rs * g1);
        }
    }
}

struct KVSrc { const bf16_t* k; long kp; const bf16_t* k2; long k2p; const bf16_t* v; long vp; };
typedef short v4i16_t __attribute__((ext_vector_type(4)));
__device__ __forceinline__ s16x4 vtr(const LAS unsigned char* p) { return __builtin_bit_cast(s16x4, __builtin_amdgcn_ds_read_tr16_b64_v4i16((LAS v4i16_t*)p)); }

constexpr int ATT_TAB = 0, ATT_BUF = 1024;

template <int DQK, int DV, bool BIAS, int TK>
__device__ __forceinline__ void flash_pass(LAS unsigned char* lds, const KVSrc& S, int uc0, int uc1, int wc0, int wc1, int nkeys,
                                           const bf16x8 (&qf)[DQK / 16], int qpos, int qpos_w0, int kpos0, f32x16 (&o)[DV / 32], float& m_run, float& l_run) {
    constexpr int KP = DQK * 2 + 16, VP = DV * 2 + 64, KBUF = TK * KP, VBUF = TK * VP, KCH = DQK / 8, VCH = DV / 8, NKI = TK * KCH / 512, NVI = TK * VCH / 512, NPB = TK / 32, NST = TK / 16;
    static_assert((TK == 64 || TK == 128) && TK * KCH % 512 == 0 && TK * VCH % 512 == 0 && ATT_BUF + 2 * (KBUF + VBUF) <= 131072, "attention tile geometry");
    const int tid = opq_tid(), lane = tid & 63, l31 = lane & 31, hi = lane >> 5;
    LAS unsigned char* kb0 = lds + ATT_BUF; LAS unsigned char* vb0 = lds + ATT_BUF + 2 * KBUF;
    const LAS float* tab = (const LAS float*)(lds + ATT_TAB);
    const int t0 = (uc0 * 64) / TK, t1 = (uc1 * 64 + TK - 1) / TK;
    if (t0 >= t1) return;
    const int klo = 64 * wc0, khi = (64 * wc1 < nkeys) ? 64 * wc1 : nkeys;
    const int w0 = klo / TK, w1 = khi > klo ? (khi + TK - 1) / TK : w0;
    u32x4 kreg[NKI], vreg[NVI];
#define ATT_LOAD(t) do { \
        _Pragma("unroll") for (int i = 0; i < NKI; ++i) { const int c = tid + i * 512; const int r = c / KCH, cc = c % KCH; const long kr = (long)(t) * TK + r; \
            const bf16_t* src = (DQK == 96 && cc >= 8) ? S.k2 + kr * S.k2p + (cc - 8) * 8 : S.k + kr * S.kp + cc * 8; kreg[i] = *(const u32x4*)src; } \
        _Pragma("unroll") for (int i = 0; i < NVI; ++i) { const int c = tid + i * 512; const int r = c / VCH, cc = c % VCH; vreg[i] = *(const u32x4*)(S.v + ((long)(t) * TK + r) * S.vp + cc * 8); } } while (0)
#define ATT_STORE(b) do { \
        _Pragma("unroll") for (int i = 0; i < NKI; ++i) { const int c = tid + i * 512; const int r = c / KCH, cc = c % KCH; *(LAS u32x4*)(kb0 + (b) * KBUF + r * KP + cc * 16) = kreg[i]; } \
        _Pragma("unroll") for (int i = 0; i < NVI; ++i) { const int c = tid + i * 512; const int r = c / VCH, cc = c % VCH; *(LAS u32x4*)(vb0 + (b) * VBUF + r * VP + cc * 16) = vreg[i]; } } while (0)
    ATT_LOAD(t0); ATT_STORE(0); __syncthreads();
    const int koff = l31 * KP + hi * 16;
    const int voff = (4 * hi + ((lane & 15) >> 2)) * VP + (16 * ((lane >> 4) & 1) + 4 * (lane & 3)) * 2;
    for (int t = t0; t < t1; ++t) {
        const int cur = (t - t0) & 1;
        ATT_LOAD((t + 1 < t1 ? t + 1 : t1 - 1));
        if (t >= w0 && t < w1) {
            const LAS unsigned char* kb = kb0 + cur * KBUF + koff; const LAS unsigned char* vb = vb0 + cur * VBUF + voff;
            f32x16 p[NPB];
#pragma unroll
            for (int q = 0; q < NPB; ++q)
#pragma unroll
                for (int r = 0; r < 16; ++r) p[q][r] = 0.f;
#pragma unroll
            for (int ks = 0; ks < DQK / 16; ++ks)
#pragma unroll
                for (int q = 0; q < NPB; ++q) {
                    const bf16x8 a = *(const LAS bf16x8*)(kb + q * 32 * KP + ks * 32);
                    p[q] = __builtin_amdgcn_mfma_f32_32x32x16_bf16(a, qf[ks], p[q], 0, 0, 0);
                }
            __builtin_amdgcn_sched_barrier(0);
            asm volatile("s_nop 15\n\ts_nop 15" ::: "memory");
            const int tk0 = t * TK;
            if (BIAS) {
                const int tkpos = kpos0 + tk0;
                if (qpos_w0 - (tkpos + TK - 64) >= 192) { const float c = tab[254];
#pragma unroll
                    for (int q = 0; q < NPB; ++q)
#pragma unroll
                        for (int r = 0; r < 16; ++r) p[q][r] += c; }
                else { const int base = qpos - (tkpos + 4 * hi) + 63;
#pragma unroll
                    for (int q = 0; q < NPB; ++q)
#pragma unroll
                        for (int r = 0; r < 16; ++r) { int i0 = base - ((r & 3) + 8 * (r >> 2)) - 32 * q; i0 = i0 > 254 ? 254 : i0; p[q][r] += tab[i0]; } }
            }
            if (tk0 < klo || tk0 + TK > khi) {
                asm volatile("" ::: "memory");
#pragma unroll
                for (int q = 0; q < NPB; ++q)
#pragma unroll
                    for (int r = 0; r < 16; ++r) { const int key = tk0 + 32 * q + 4 * hi + (r & 3) + 8 * (r >> 2); if (key < klo || key >= khi) p[q][r] = NEGBIG; }
            }
            float mxa = max3f(p[0][0], p[0][1], p[1][0]), mxb = max3f(p[0][2], p[0][3], p[1][1]); mxa = max3f(mxa, p[1][2], p[1][3]);
#pragma unroll
            for (int r = 4; r < 16; r += 4) { mxa = max3f(mxa, p[0][r], p[0][r + 1]); mxb = max3f(mxb, p[0][r + 2], p[0][r + 3]); mxa = max3f(mxa, p[1][r], p[1][r + 1]); mxb = max3f(mxb, p[1][r + 2], p[1][r + 3]); }
            if constexpr (NPB == 4) {
#pragma unroll
                for (int r = 0; r < 16; r += 4) { mxa = max3f(mxa, p[2][r], p[2][r + 1]); mxb = max3f(mxb, p[2][r + 2], p[2][r + 3]); mxa = max3f(mxa, p[3][r], p[3][r + 1]); mxb = max3f(mxb, p[3][r + 2], p[3][r + 3]); }
            }
            float mt = max3f(mxa, mxb, mxa);
            mt = max3f(mt, __shfl_xor(mt, 32), mt);
            float alpha = 1.0f;
            if (__builtin_amdgcn_ballot_w64(mt > m_run + 8.0f) != 0ull) {
                const float mnew = max3f(m_run, mt, mt); alpha = fast_exp2(m_run - mnew); m_run = mnew;
#pragma unroll
                for (int db = 0; db < DV / 32; ++db) o[db] *= alpha;
            }
            const float mnew = m_run;
            typedef float f32x2v __attribute__((ext_vector_type(2)));
            const f32x2v mm = {mnew, mnew}; f32x2v sum2 = {0.f, 0.f};
#pragma unroll
            for (int q = 0; q < NPB; ++q)
#pragma unroll
                for (int r = 0; r < 16; r += 2) {
                    f32x2v a = (f32x2v){p[q][r], p[q][r + 1]} - mm;
                    a.x = fast_exp2(a.x); a.y = fast_exp2(a.y);
                    p[q][r] = a.x; p[q][r + 1] = a.y; sum2 += a;
                }
            const float sum = sum2.x + sum2.y;
            l_run = l_run * alpha + sum;
            __builtin_amdgcn_sched_barrier(0);
            bf16x8 pf[NST];
#pragma unroll
            for (int s = 0; s < NST; ++s) {
                const int q = s >> 1, h8 = (s & 1) * 8; u32x4 w;
                w.x = cvtpk_c(p[q][h8 + 0], p[q][h8 + 1]); w.y = cvtpk_c(p[q][h8 + 2], p[q][h8 + 3]); w.z = cvtpk_c(p[q][h8 + 4], p[q][h8 + 5]); w.w = cvtpk_c(p[q][h8 + 6], p[q][h8 + 7]);
                pf[s] = __builtin_bit_cast(bf16x8, w);
            }
#pragma unroll
            for (int db = 0; db < DV / 32; ++db)
#pragma unroll
                for (int s = 0; s < NST; ++s) {
                    const s16x4 lo = vtr(vb + (16 * s) * VP + db * 64), hh = vtr(vb + (16 * s + 8) * VP + db * 64);
                    const bf16x8 vf = (bf16x8){lo[0], lo[1], lo[2], lo[3], hh[0], hh[1], hh[2], hh[3]};
                    o[db] = __builtin_amdgcn_mfma_f32_32x32x16_bf16(vf, pf[s], o[db], 0, 0, 0);
                    if ((s & 3) == 3) __builtin_amdgcn_sched_barrier(0);
                }
        }
        ATT_STORE(cur ^ 1);
#ifdef PROBE_STAGE2
        ATT_LOAD((t + 1 < t1 ? t + 1 : t1 - 1)); asm volatile("" ::: "memory"); ATT_STORE(cur ^ 1);
#endif
        __syncthreads();
    }
#undef ATT_LOAD
#undef ATT_STORE
}

template <int NQF> __device__ __forceinline__ void load_q(bf16x8 (&qf)[NQF], const bf16_t* qrow, int hi) {
#pragma unroll
    for (int ks = 0; ks < NQF; ++ks) qf[ks] = *(const bf16x8*)(qrow + 16 * ks + 8 * hi);
}
template <int NDB> __device__ __forceinline__ void store_o(bf16_t* orow, const f32x16 (&o)[NDB], float inv, int hi, bool valid) {
    if (!valid) return;
#pragma unroll
    for (int db = 0; db < NDB; ++db)
#pragma unroll
        for (int g = 0; g < 4; ++g) {
            u32x2 w; w.x = cvt_pk_bf16(o[db][4 * g] * inv, o[db][4 * g + 1] * inv); w.y = cvt_pk_bf16(o[db][4 * g + 2] * inv, o[db][4 * g + 3] * inv);
            *(u32x2*)(orow + 32 * db + 8 * g + 4 * hi) = w;
        }
}

__device__ __forceinline__ int t5_bucket(int rel) {
    const int n = rel < 0 ? -rel : rel; int b;
    if (n < 8) b = n; else if (n < 12) b = 8; else if (n < 16) b = 9; else if (n < 23) b = 10; else if (n < 32) b = 11; else if (n < 46) b = 12; else if (n < 64) b = 13; else if (n < 91) b = 14; else b = 15;
    return b + (rel > 0 ? 16 : 0);
}

__device__ __forceinline__ void attn_a(LAS unsigned char* lds, const Params& P) {
    unsigned char* ws = P.ws; const int tid = opq_tid(), lane = tid & 63, w = tid >> 6, l31 = lane & 31, hi = lane >> 5;
    bf16_t* O = (bf16_t*)(ws + WS_O); const bf16_t* QA = (const bf16_t*)(ws + WS_QA);
    LAS float* tab = (LAS float*)(lds + ATT_TAB);
    for (int u0 = opq_bid(); u0 < 1024 + 256; u0 += gridDim.x) {
        if (u0 >= 1024 && (((u0 - 1024) >> 3) & 1) == 0) continue;
        const int u = u0 >= 1024 ? 1024 + (((u0 - 1024) >> 4) * 8 + ((u0 - 1024) & 7)) : u0;
        const bool sample = u >= 1024; int b, h, qb = 0;
        if (!sample) { const int r = u >> 8, c = u & 255, xc = c & 7, j = c >> 3; const int bh = xc * 16 + (j >> 1); qb = 2 * r + (j & 1); b = bh >> 3; h = bh & 7; }
        else { const int s = u - 1024; b = s >> 3; h = s & 7; }
        if (tid < 256) { int rel = tid - 63; rel = rel > 64 ? 64 : rel; tab[tid] = P.in[17][h * 129 + rel + 64] * LOG2E; }
        KVSrc S; int t0, t1, w0, w1, nkeys, qpos, qpos_w0, kpos0; long qrow; bool valid;
        if (!sample) {
            const size_t base = (size_t)b * SEQ * 512 + h * 64;
            S = KVSrc{(const bf16_t*)(ws + WS_KA) + base, 512, nullptr, 0, (const bf16_t*)(ws + WS_VA) + base, 512};
            const int c0 = qb * 4, cw = c0 + (w >> 1);
            t0 = c0 - 8 < 0 ? 0 : c0 - 8; t1 = c0 + 4; w0 = cw - 8 < 0 ? 0 : cw - 8; w1 = cw + 1; nkeys = SEQ;
            qpos_w0 = qb * 256 + (w >> 1) * 64; qpos = qb * 256 + w * 32 + l31; kpos0 = 0; qrow = (long)b * SEQ + qpos; valid = true;
        } else {
            const size_t base = (size_t)b * KA_ROWS * 512 + h * 64;
            S = KVSrc{(const bf16_t*)(ws + WS_KAS) + base, 512, nullptr, 0, (const bf16_t*)(ws + WS_VAS) + base, 512};
            t0 = 0; t1 = 9; w0 = 0; w1 = (w == 0) ? 9 : 0; nkeys = 512 + NEW;
            qpos_w0 = PAST; qpos = PAST + (l31 & 15); kpos0 = PAST - 512; qrow = (long)TP + b * NEW + (l31 & 15); valid = (w == 0) && l31 < 16;
        }
        bf16x8 qf[4]; load_q<4>(qf, QA + qrow * 512 + h * 64, hi);
        f32x16 o[2];
#pragma unroll
        for (int db = 0; db < 2; ++db)
#pragma unroll
            for (int r = 0; r < 16; ++r) o[db][r] = 0.f;
        float m_run = NEGBIG, l_run = 0.f;
        flash_pass<64, 64, true, 128>(lds, S, t0, t1, w0, w1, nkeys, qf, qpos, qpos_w0, kpos0, o, m_run, l_run);
        l_run += __shfl_xor(l_run, 32);
        store_o<2>(O + qrow * 1024 + h * 64, o, 1.0f / l_run, hi, valid);
    }
}

__device__ __forceinline__ float diff_lambda(const Params& P) {
    float d1 = 0.f, d2 = 0.f;
    for (int i = 0; i < 64; ++i) { d1 += P.in[18][i] * P.in[19][i]; d2 += P.in[20][i] * P.in[21][i]; }
    return expf(d1) - expf(d2) + 0.2f;
}
__device__ __forceinline__ void attn_b(LAS unsigned char* lds, const Params& P) {
    unsigned char* ws = P.ws; const int tid = opq_tid(), lane = tid & 63, w = tid >> 6, l31 = lane & 31, hi = lane >> 5;
    bf16_t* O = (bf16_t*)(ws + WS_O); bf16_t* OT1 = (bf16_t*)(ws + WS_OT1); const bf16_t* QB = (const bf16_t*)(ws + WS_QB);
    LAS float* tab = (LAS float*)(lds + ATT_TAB);
    for (int u0 = opq_bid(); u0 < 1024 + 256; u0 += gridDim.x) {
        if (u0 >= 1024 && (((u0 - 1024) >> 3) & 1) == 1) continue;
        const int u = u0 >= 1024 ? 1024 + (((u0 - 1024) >> 4) * 8 + ((u0 - 1024) & 7)) : u0;
        const bool sample = u >= 1024; int b, h, mp, qb = 0;
        if (!sample) { const int r = u >> 8, c = u & 255, xc = c & 7, j = c >> 3; const int bhm = (xc * 8 + (j >> 2)) * 2 + ((j >> 1) & 1), p2 = j & 1; qb = p2 == 0 ? (r == 0 ? 0 : r == 1 ? 7 : r == 2 ? 2 : 5) : (r == 0 ? 1 : r == 1 ? 6 : r == 2 ? 3 : 4); b = bhm >> 3; h = (bhm >> 1) & 3; mp = bhm & 1; }
        else { const int s = u - 1024; b = s >> 3; h = (s >> 1) & 3; mp = s & 1; }
        if (tid < 256) tab[tid] = P.in[8][t5_bucket(63 - tid) * 4 + h] * LOG2E;
        int t0, t1, w0, w1, nkeys, qpos, qpos_w0; long qrow; bool valid; size_t kbase; const bf16_t *kp, *vp;
        if (!sample) {
            kbase = (size_t)b * SEQ * 512 + h * 128; kp = (const bf16_t*)(ws + WS_KB); vp = (const bf16_t*)(ws + WS_VB);
            const int c0 = qb * 4, cw = c0 + (w >> 1);
            t0 = 0; t1 = c0 + 4; w0 = 0; w1 = cw + 1; nkeys = SEQ;
            qpos_w0 = qb * 256 + (w >> 1) * 64; qpos = qb * 256 + w * 32 + l31; qrow = (long)b * SEQ + qpos; valid = true;
        } else {
            kbase = (size_t)b * KB_ROWS * 512 + h * 128; kp = (const bf16_t*)(ws + WS_KBS); vp = (const bf16_t*)(ws + WS_VBS);
            t0 = 0; t1 = 17; w0 = 0; w1 = (w == 0) ? 17 : 0; nkeys = PAST + NEW;
            qpos_w0 = PAST; qpos = PAST + (l31 & 15); qrow = (long)TP + b * NEW + (l31 & 15); valid = (w == 0) && l31 < 16;
        }
        KVSrc S{kp + kbase + mp * 64, 512, nullptr, 0, vp + kbase, 512};
        bf16x8 qf[4]; load_q<4>(qf, QB + qrow * 512 + h * 128 + mp * 64, hi);
        f32x16 o[4];
#pragma unroll
        for (int db = 0; db < 4; ++db)
#pragma unroll
            for (int r = 0; r < 16; ++r) o[db][r] = 0.f;
        float m_run = NEGBIG, l_run = 0.f;
        flash_pass<64, 128, true, 64>(lds, S, t0, t1, w0, w1, nkeys, qf, qpos, qpos_w0, 0, o, m_run, l_run);
        l_run += __shfl_xor(l_run, 32);
        store_o<4>(mp == 0 ? O + qrow * 1024 + 512 + h * 128 : OT1 + qrow * 512 + h * 128, o, 1.0f / l_run, hi, valid);
    }
}
__device__ __forceinline__ void combine_b(const Params& P) {
    unsigned char* ws = P.ws; const int tid = opq_tid(), lane = tid & 63, gw = opq_bid() * 8 + (tid >> 6), nw = gridDim.x * 8;
    bf16_t* O = (bf16_t*)(ws + WS_O); const bf16_t* OT1 = (const bf16_t*)(ws + WS_OT1);
    const float lam = diff_lambda(P), lam_init = 0.2f;
    const int h = lane >> 4, e = (lane & 15) * 8;
    const f32x4 g0 = *(const f32x4*)(P.in[22] + e), g1 = *(const f32x4*)(P.in[22] + e + 4);
    constexpr int NR = 4;
    for (int row0 = gw; row0 < MT; row0 += NR * nw) {
        u32x4 w0[NR], w1[NR];
#pragma unroll
        for (int q = 0; q < NR; ++q) { const int row = row0 + q * nw < MT ? row0 + q * nw : 0;
            w0[q] = *(const u32x4*)(O + (size_t)row * 1024 + 512 + h * 128 + e); w1[q] = *(const u32x4*)(OT1 + (size_t)row * 512 + h * 128 + e); }
#pragma unroll
        for (int q = 0; q < NR; ++q) { const int row = row0 + q * nw; if (row >= MT) continue;
            f32x4 a0, b0, a1, b1; unpack8(w0[q], a0, b0); unpack8(w1[q], a1, b1);
            a0 -= a1 * lam; b0 -= b1 * lam;
            float ss = (a0[0] * a0[0] + a0[1] * a0[1]) + (a0[2] * a0[2] + a0[3] * a0[3]) + (b0[0] * b0[0] + b0[1] * b0[1]) + (b0[2] * b0[2] + b0[3] * b0[3]);
            ss += __shfl_xor(ss, 1); ss += __shfl_xor(ss, 2); ss += __shfl_xor(ss, 4); ss += __shfl_xor(ss, 8);
            const float rs = rsqrtf(ss * (1.0f / 128.0f) + EPS) * (1.0f - lam_init);
            *(u32x4*)(O + (size_t)row * 1024 + 512 + h * 128 + e) = pack8(a0 * rs * g0, b0 * rs * g1); }
    }
}

__device__ __forceinline__ void attn_c(LAS unsigned char* lds, const Params& P) {
    unsigned char* ws = P.ws; const int tid = opq_tid(), lane = tid & 63, w = tid >> 6, l31 = lane & 31, hi = lane >> 5;
    bf16_t* O = (bf16_t*)(ws + WS_O); const bf16_t* QC = (const bf16_t*)(ws + WS_QC);
    const bf16_t* KVC = (const bf16_t*)(ws + WS_KVC); const bf16_t* KRB = (const bf16_t*)(ws + WS_KRB);
    for (int u = opq_bid(); u < 2048 + 256; u += gridDim.x) {
        const bool sample = u >= 2048; int b, h, qb = 0;
        if (!sample) { const int r = u >> 8, c = u & 255, xc = c & 7, j = c >> 3; const int bh = (r >> 1) * 64 + xc * 8 + (j >> 2), m4 = j & 3; qb = (r & 1) ? 7 - m4 : m4; b = bh >> 4; h = bh & 15; }
        else { const int s = u - 2048; b = s >> 4; h = s & 15; }
        int t0, t1, w0, w1, nkeys, qpos, qpos_w0; long qrow, krow0; bool valid;
        if (!sample) {
            krow0 = (long)b * SEQ; const int c0 = qb * 4, cw = c0 + (w >> 1);
            t0 = 0; t1 = c0 + 4; w0 = 0; w1 = cw + 1; nkeys = SEQ;
            qpos_w0 = qb * 256 + (w >> 1) * 64; qpos = qb * 256 + w * 32 + l31; qrow = (long)b * SEQ + qpos; valid = true;
        } else {
            krow0 = (long)TP + (long)b * (PAST + NEW);
            t0 = 0; t1 = 17; w0 = 0; w1 = (w == 0) ? 17 : 0; nkeys = PAST + NEW;
            qpos_w0 = PAST; qpos = PAST + (l31 & 15); qrow = (long)TP + b * NEW + (l31 & 15); valid = (w == 0) && l31 < 16;
        }
        const bf16_t* kvh = sample ? KVC + KVC_S_OFF + ((size_t)(b * 16 + h) * KC_ROWS) * 128 : KVC + ((size_t)(b * 16 + h) * SEQ) * 128;
        KVSrc S{kvh, 128, KRB + krow0 * 32, 32, kvh + 64, 128};
        bf16x8 qf[6]; load_q<6>(qf, QC + qrow * 1536 + h * 96, hi);
        f32x16 o[2];
#pragma unroll
        for (int db = 0; db < 2; ++db)
#pragma unroll
            for (int r = 0; r < 16; ++r) o[db][r] = 0.f;
        float m_run = NEGBIG, l_run = 0.f;
        flash_pass<96, 64, false, 128>(lds, S, t0, t1, w0, w1, nkeys, qf, qpos, qpos_w0, 0, o, m_run, l_run);
        l_run += __shfl_xor(l_run, 32);
        store_o<2>(O + qrow * 1024 + h * 64, o, 1.0f / l_run, hi, valid);
    }
}

#define XB_TMO      128
#define XB_XCNT(j)  (256  + 64 * (j))
#define XB_XSUB(j)  (1280 + 64 * (j))
#define XB_XGEN(j)  (2304 + 64 * (j))
#define XB_TOP      3328
#define XB_TOPGEN   3392
#define XCD_BAR_WORDS 3456
#define XB_SPIN_CAP (1u << 18)

__device__ __forceinline__ unsigned xb_ld(unsigned* p)              { return __hip_atomic_load(p, __ATOMIC_RELAXED, __HIP_MEMORY_SCOPE_AGENT); }
__device__ __forceinline__ unsigned xb_add(unsigned* p, unsigned v) { return __hip_atomic_fetch_add(p, v, __ATOMIC_RELAXED, __HIP_MEMORY_SCOPE_AGENT); }
__device__ __forceinline__ unsigned xb_xcc_id() { return (unsigned)__builtin_amdgcn_s_getreg((3 << 11) | 20) & 0xFu; }
#define XB_SPIN(cond, bar) do { unsigned _sp = 0; while (cond) { __builtin_amdgcn_s_sleep(1); \
    if ((++_sp & 255u) == 0u) { if (xb_ld(&(bar)[XB_TMO])) break; if (_sp > XB_SPIN_CAP) { atomicAdd(&(bar)[XB_TMO], 1u); break; } } } } while (0)

struct XcdBarrier {
    unsigned* bar; unsigned x;
    volatile LAS unsigned* st;
};

__device__ __forceinline__ XcdBarrier xcd_barrier_post(unsigned* bar, volatile LAS unsigned* st) {
    XcdBarrier b; b.bar = bar; b.x = xb_xcc_id(); b.st = st;
    if (threadIdx.x == 0) (void)xb_add(&bar[XB_XCNT(b.x)], 1u);
    return b;
}
__device__ __forceinline__ void xcd_barrier_complete(unsigned* bar, unsigned x, unsigned& nloc, unsigned& nx) {
    const unsigned G = gridDim.x * gridDim.y * gridDim.z;
    unsigned sum, cnt, mine, sp = 0u;
    for (;;) {
        sum = 0u; cnt = 0u; mine = 0u;
#pragma unroll
        for (unsigned j = 0; j < 16; ++j) { const unsigned c = xb_ld(&bar[XB_XCNT(j)]); sum += c; cnt += (c > 0u) ? 1u : 0u; mine = (j == x) ? c : mine; }
        if (sum == G) break;
        __builtin_amdgcn_s_sleep(1);
        if ((++sp & 255u) == 0u) { if (xb_ld(&bar[XB_TMO])) break; if (sp > XB_SPIN_CAP) { atomicAdd(&bar[XB_TMO], 1u); break; } }
    }
    nloc = mine > 0u ? mine : 1u; nx = cnt > 0u ? cnt : 1u;
}

__device__ __forceinline__ void xcd_barrier(const XcdBarrier& b) {
    asm volatile("s_waitcnt vmcnt(0)" ::: "memory");
    __syncthreads();
    if (threadIdx.x == 0) {
        unsigned* bar = b.bar;
        __builtin_amdgcn_s_waitcnt(0);
        unsigned nloc = b.st[0], nx = b.st[1];
        if (nloc == 0u) { xcd_barrier_complete(bar, b.x, nloc, nx); b.st[0] = nloc; b.st[1] = nx; }
        const unsigned old = xb_add(&bar[XB_XSUB(b.x)], 1u);
        const unsigned gen = old / nloc;
        if (old + 1u == (gen + 1u) * nloc) {
            __builtin_amdgcn_fence(__ATOMIC_RELEASE, "agent");
            asm volatile("s_waitcnt vmcnt(0)" ::: "memory");
            const unsigned og = xb_add(&bar[XB_TOP], 1u);
            const unsigned tg = og / nx;
            if (og + 1u == (tg + 1u) * nx) xb_add(&bar[XB_TOPGEN], 1u);
            else XB_SPIN(xb_ld(&bar[XB_TOPGEN]) == tg, bar);
            __builtin_amdgcn_fence(__ATOMIC_ACQUIRE, "agent");
            xb_add(&bar[XB_XGEN(b.x)], 1u);
            asm volatile("s_waitcnt vmcnt(0)" ::: "memory");
        } else {
            XB_SPIN(xb_ld(&bar[XB_XGEN(b.x)]) == gen, bar);
            __builtin_amdgcn_fence(__ATOMIC_ACQUIRE, "agent");
            asm volatile("s_waitcnt vmcnt(0)" ::: "memory");
        }
    }
    __syncthreads();
}


constexpr int N_PHASES = 18;
__global__ void __launch_bounds__(512, 2) fwd_megakernel(Params P) {
    extern __shared__ __attribute__((aligned(16))) unsigned char lds_raw[];
    LAS unsigned char* lds = (LAS unsigned char*)lds_raw;
    cg::grid_group grid = cg::this_grid();
    unsigned char* ws = P.ws; float* x = P.out;
    bf16_t* xb = (bf16_t*)(ws + WS_XB); float* ssp = (float*)(ws + WS_SSP); float* ssps = (float*)(ws + WS_SSPS); bf16_t* act = (bf16_t*)(ws + WS_ACT); bf16_t* O = (bf16_t*)(ws + WS_O);
    const int lo = P.ph_lo, hi = P.ph_hi;
    volatile LAS unsigned* bst = (volatile LAS unsigned*)(lds + 131072);
    if (threadIdx.x < 2) bst[threadIdx.x] = 0u;
    __syncthreads();
    XcdBarrier bar = xcd_barrier_post((unsigned*)(ws + WS_CTL), bst);
#define PH(k) if (lo <= (k) && (k) < hi)
#define SEAM(k) if (lo <= (k) && (k) + 1 < hi) { xcd_barrier(bar); }
    if (lo < 0) grid.sync();
    PH(0) { prologue(lds, P);
#ifdef PROBE_PRO2
        prologue(lds, P);
#endif
    } SEAM(0)
#define WGU(i) ((const bf16_t*)(ws + W_GU + (size_t)(i) * W_GU_SZ))
#define WDN(i) ((const bf16_t*)(ws + W_DN + (size_t)(i) * W_DN_SZ))
    PH(1) { skinny_gemm<4, 4>(xb + (size_t)TP * D, WGU(0), D, FF / 32, SkSwiglu4{act, ssps}); run_gemm(lds, xb, WGU(0), TP, 2 * FF, D, EpiSwiglu{act, ssp});
#ifdef PROBE_UP2
        skinny_gemm<4, 4>(xb + (size_t)TP * D, WGU(0), D, FF / 32, SkSwiglu4{act, ssps}); run_gemm(lds, xb, WGU(0), TP, 2 * FF, D, EpiSwiglu{act, ssp});
#endif
    } SEAM(1)
    PH(2) {
#ifdef PROBE_DN2
        skinny_gemm<1, 11>(act + (size_t)TP * FF, WDN(0), FF, D / 16, SkResid{x, xb, ssps, 0.25f}); run_gemm(lds, act, WDN(0), TP, D, FF, EpiResid{x, xb, ssp, 0.25f});
        skinny_gemm<1, 11>(act + (size_t)TP * FF, WDN(0), FF, D / 16, SkResid{x, xb, ssps, 0.25f}); run_gemm(lds, act, WDN(0), TP, D, FF, EpiResid{x, xb, ssp, 0.25f});
#else
        skinny_gemm<1, 11, SkResid, 2>(act + (size_t)TP * FF, WDN(0), FF, D / 16, SkResid{x, xb, ssps, 0.5f}, 0, lds); run_gemm(lds, act, WDN(0), TP, D, FF, EpiResid{x, xb, ssp, 0.5f});
#endif
 } SEAM(2)
    PH(3) { skinny_gemm<2, 8>(xb + (size_t)TP * D, (const bf16_t*)(ws + W_IN0), D, 96, SkIn0{ssps, ws, P.out}); run_gemm(lds, xb, (const bf16_t*)(ws + W_IN0), TP, 3072, D, EpiIn0{ssp, ws, P.out}); } SEAM(3)
    PH(4) {
#ifndef DIS_A
        attn_a(lds, P);
#endif
#ifndef DIS_B
        attn_b(lds, P);
#endif
#ifdef PROBE_ATT2
        attn_a(lds, P); attn_b(lds, P);
#endif
        if (hi > 5) { xcd_barrier(bar); combine_b(P); }
    } SEAM(4)
    PH(5) { skinny_gemm<1, 4, SkResid, 2>(O + (size_t)TP * D, (const bf16_t*)(ws + W_OUT0), D, D / 16, SkResid{x, xb, ssps, 1.0f}, 0, lds); run_gemm(lds, O, (const bf16_t*)(ws + W_OUT0), TP, D, D, EpiResid{x, xb, ssp, 1.0f}); } SEAM(5)
    PH(6) { skinny_gemm<4, 4>(xb + (size_t)TP * D, WGU(1), D, FF / 32, SkSwiglu4{act, ssps}); run_gemm(lds, xb, WGU(1), TP, 2 * FF, D, EpiSwiglu{act, ssp});
#ifdef PROBE_UP2
        skinny_gemm<4, 4>(xb + (size_t)TP * D, WGU(1), D, FF / 32, SkSwiglu4{act, ssps}); run_gemm(lds, xb, WGU(1), TP, 2 * FF, D, EpiSwiglu{act, ssp});
#endif
    } SEAM(6)
    PH(7) {
#ifdef PROBE_DN2
        skinny_gemm<1, 11>(act + (size_t)TP * FF, WDN(1), FF, D / 16, SkResid{x, xb, ssps, 0.25f}); run_gemm(lds, act, WDN(1), TP, D, FF, EpiResid{x, xb, ssp, 0.25f});
        skinny_gemm<1, 11>(act + (size_t)TP * FF, WDN(1), FF, D / 16, SkResid{x, xb, ssps, 0.25f}); run_gemm(lds, act, WDN(1), TP, D, FF, EpiResid{x, xb, ssp, 0.25f});
#else
        skinny_gemm<1, 11, SkResid, 2>(act + (size_t)TP * FF, WDN(1), FF, D / 16, SkResid{x, xb, ssps, 0.5f}, 0, lds); run_gemm(lds, act, WDN(1), TP, D, FF, EpiResid{x, xb, ssp, 0.5f});
#endif
 } SEAM(7)
    PH(8) { skinny_gemm<4, 4>(xb + (size_t)TP * D, WGU(2), D, FF / 32, SkSwiglu4{act, ssps}); run_gemm(lds, xb, WGU(2), TP, 2 * FF, D, EpiSwiglu{act, ssp});
#ifdef PROBE_UP2
        skinny_gemm<4, 4>(xb + (size_t)TP * D, WGU(2), D, FF / 32, SkSwiglu4{act, ssps}); run_gemm(lds, xb, WGU(2), TP, 2 * FF, D, EpiSwiglu{act, ssp});
#endif
    } SEAM(8)
    PH(9) {
#ifdef PROBE_DN2
        skinny_gemm<1, 11>(act + (size_t)TP * FF, WDN(2), FF, D / 16, SkResid{x, xb, ssps, 0.25f}); run_gemm(lds, act, WDN(2), TP, D, FF, EpiResid{x, xb, ssp, 0.25f});
        skinny_gemm<1, 11>(act + (size_t)TP * FF, WDN(2), FF, D / 16, SkResid{x, xb, ssps, 0.25f}); run_gemm(lds, act, WDN(2), TP, D, FF, EpiResid{x, xb, ssp, 0.25f});
#else
        skinny_gemm<1, 11, SkResid, 2>(act + (size_t)TP * FF, WDN(2), FF, D / 16, SkResid{x, xb, ssps, 0.5f}, 0, lds); run_gemm(lds, act, WDN(2), TP, D, FF, EpiResid{x, xb, ssp, 0.5f});
#endif
 } SEAM(9)
    PH(10) {
        const int G = (int)gridDim.x, half = G / 2;
        if ((int)blockIdx.x >= half) prologue_l1(P, (int)blockIdx.x - half, G - half);
        skinny_gemm<1, 8>(xb + (size_t)TP * D, (const bf16_t*)(ws + W_IN1), D, 42, SkIn1{ssps, ws, P.out}, half); run_gemm(lds, xb, (const bf16_t*)(ws + W_IN1), TP, 768, D, EpiIn1{ssp, ws, P.out}); } SEAM(10)
    PH(11) { thin_l1(P); skinny_gemm<1, 6>((const bf16_t*)(ws + WS_CQ) + (size_t)TP * 384, (const bf16_t*)(ws + W_QUP), 384, 96, SkQup{ws}); run_gemm(lds, (const bf16_t*)(ws + WS_CQ), (const bf16_t*)(ws + W_QUP), TP, 1536, 384, EpiQup{ws}); } SEAM(11)
    PH(12) { skinny_gemm<1, 4>((const bf16_t*)(ws + WS_CKVN) + (size_t)(MKV - 256) * 256, (const bf16_t*)(ws + W_KVUP), 256, 128, SkKvHead{(bf16_t*)(ws + WS_KVC)});
        run_gemm(lds, (const bf16_t*)(ws + WS_CKVN), (const bf16_t*)(ws + W_KVUP), MKV - 256, 2048, 256, EpiKvHead{(bf16_t*)(ws + WS_KVC)}); } SEAM(12)
    PH(13) {
#ifndef DIS_C
        attn_c(lds, P);
#endif
#ifdef PROBE_ATTC2
        attn_c(lds, P);
#endif
    } SEAM(13)
    PH(14) { skinny_gemm<1, 4, SkResid, 2>(O + (size_t)TP * D, (const bf16_t*)(ws + W_OUT1), D, D / 16, SkResid{x, xb, ssps, 1.0f}, 0, lds); run_gemm(lds, O, (const bf16_t*)(ws + W_OUT1), TP, D, D, EpiResid{x, xb, ssp, 1.0f}); } SEAM(14)
    PH(15) { skinny_gemm<4, 4>(xb + (size_t)TP * D, WGU(3), D, FF / 32, SkSwiglu4{act, ssps}); run_gemm(lds, xb, WGU(3), TP, 2 * FF, D, EpiSwiglu{act, ssp});
#ifdef PROBE_UP2
        skinny_gemm<4, 4>(xb + (size_t)TP * D, WGU(3), D, FF / 32, SkSwiglu4{act, ssps}); run_gemm(lds, xb, WGU(3), TP, 2 * FF, D, EpiSwiglu{act, ssp});
#endif
    } SEAM(15)
    PH(16) {
#ifdef PROBE_DN2
        skinny_gemm<1, 11>(act + (size_t)TP * FF, WDN(3), FF, D / 16, SkResid{x, xb, ssps, 0.25f}); run_gemm(lds, act, WDN(3), TP, D, FF, EpiResid{x, xb, ssp, 0.25f});
        skinny_gemm<1, 11>(act + (size_t)TP * FF, WDN(3), FF, D / 16, SkResid{x, xb, ssps, 0.25f}); run_gemm(lds, act, WDN(3), TP, D, FF, EpiResid{x, xb, ssp, 0.25f});
#else
        skinny_gemm<1, 11, SkResid, 2>(act + (size_t)TP * FF, WDN(3), FF, D / 16, SkResid{x, xb, ssps, 0.5f}, 0, lds); run_gemm(lds, act, WDN(3), TP, D, FF, EpiResid{x, xb, ssp, 0.5f});
#endif
 } SEAM(16)
    const int ph = 17;
    PH(ph) { final_norm(P); }
#undef PH
#undef SEAM
}

#ifndef MK_SPLIT
#define MK_SPLIT 0
#endif
extern "C" void kernel_launch(void* const* d_in, const int* in_sizes, int n_in, void* d_out, int out_size, void* d_ws, size_t ws_size, hipStream_t stream) {
    static int grid_blocks = 0;
    if (grid_blocks == 0) {
        if (n_in != 31 || (size_t)out_size != O_END || ws_size < WS_CTL + CTL_BYTES) { fprintf(stderr, "kernel_launch: unexpected sizes n_in %d out %d ws %zu (need %zu)\n", n_in, out_size, ws_size, (size_t)WS_END); grid_blocks = -1; return; }
        int dev = 0, cus = 0, per_cu = 0;
        hipGetDevice(&dev); hipDeviceGetAttribute(&cus, hipDeviceAttributeMultiprocessorCount, dev);
        if (hipFuncSetAttribute((const void*)fwd_megakernel, hipFuncAttributeMaxDynamicSharedMemorySize, LDS_BYTES) != hipSuccess) { fprintf(stderr, "kernel_launch: hipFuncSetAttribute failed\n"); grid_blocks = -1; return; }
        if (hipOccupancyMaxActiveBlocksPerMultiprocessor(&per_cu, (const void*)fwd_megakernel, 512, LDS_BYTES) != hipSuccess || per_cu < 1) { fprintf(stderr, "kernel_launch: occupancy query says %d\n", per_cu); per_cu = 1; }
        (void)hipGetLastError();
        grid_blocks = cus * per_cu;
        fprintf(stderr, "kernel_launch: grid %d (cus %d x %d)\n", grid_blocks, cus, per_cu);
    }
    if (grid_blocks < 0) return;
    if (hipMemsetAsync((char*)d_ws + WS_CTL, 0, CTL_BYTES, stream) != hipSuccess) { fprintf(stderr, "kernel_launch: memset failed\n"); return; }
    Params p{};
    for (int i = 0; i < 31; ++i) p.in[i] = (const float*)d_in[i];
    p.out = (float*)d_out; p.ws = (unsigned char*)d_ws;
#if MK_SPLIT
    for (int k = 0; k < N_PHASES; ++k) { p.ph_lo = k; p.ph_hi = k + 1; hipLaunchKernelGGL(fwd_megakernel, dim3(grid_blocks), dim3(512), LDS_BYTES, stream, p); }
#else
    p.ph_lo = 0; p.ph_hi = N_PHASES;
    void* args[] = {&p};
    hipError_t e = hipLaunchCooperativeKernel((const void*)fwd_megakernel, dim3(grid_blocks), dim3(512), args, LDS_BYTES, stream);
    if (e != hipSuccess) fprintf(stderr, "kernel_launch: cooperative launch failed: %s (grid %d)\n", hipGetErrorString(e), grid_blocks);
#endif
}
```
